# Optimizing an MI355X kernel written in HIP

```python
import math
import jax, jax.numpy as jnp
from jax import lax
import numpy as np

D_MODEL = 1024
BATCH = 2
SEQ = 16384
DEPTH = 4

CHUNK = 64
Q_BLOCK = 128
NORM_EPS = 1e-6
DA_HEADS = 4
DA_DK = 64
DA_DV = 2 * DA_DK
HG_HEADS = 4
HG_DK = 128
HG_DV = 128
ML_HEADS = 4
ML_DK = 128
ML_DV = 128
ML_CONV = 4
N_BRANCH = 3
BRANCH_W = 512
D_FF = 2816
N_EXPERTS = 8
TOP_K = 2
N_DENSE = (DEPTH + 1) // 2
N_MOE = DEPTH // 2

A_QK = DA_HEADS * DA_DK
COLS = (('a_q1', A_QK), ('a_q2', A_QK), ('a_k1', A_QK), ('a_k2', A_QK),
        ('a_v', DA_HEADS * DA_DV),
        ('b_q', HG_HEADS * HG_DK), ('b_f', HG_HEADS * HG_DK),
        ('b_i', HG_HEADS * HG_DV), ('b_g', HG_HEADS * HG_DV),
        ('c_qk', 2 * ML_HEADS * ML_DK), ('c_v', ML_HEADS * ML_DV),
        ('c_o', ML_HEADS * ML_DV), ('c_i', ML_HEADS), ('c_f', ML_HEADS),
        ('gate', N_BRANCH * D_MODEL))
COL_NAMES = tuple(n for n, _ in COLS)
COL_OFFSETS = tuple(int(v) for v in np.cumsum([s for _, s in COLS])[:-1])
D_IN = sum(s for _, s in COLS)

kernel_name = 'hybrid_diffattn_hgrn2_mlstm_moe_block'


def _rmsnorm(x, w):
    xf = x.astype(jnp.float32)
    y = xf * lax.rsqrt(jnp.mean(xf * xf, axis=-1, keepdims=True) + NORM_EPS)
    return (y * w.astype(jnp.float32)).astype(x.dtype)


def _modulate(xn, shift, scale):
    return xn * (1.0 + scale[:, None, :]) + shift[:, None, :]


def _swiglu(h, w1, w3, w2):
    return (jax.nn.silu(h @ w1) * (h @ w3)) @ w2


def _causal_conv(u, w, b):
    K = w.shape[0]
    S = u.shape[1]
    up = jnp.pad(u, ((0, 0), (K - 1, 0), (0, 0)))
    y = up[:, 0:S] * w[0] + b
    for j in range(1, K):
        y = y + up[:, j:j + S] * w[j]
    return y


def _diff_attention(q1, q2, k1, k2, v, lam, lam_init, qn_w, kn_w, subln_w):
    B, S, H, dk = q1.shape
    dv = v.shape[-1]
    f32 = jnp.float32
    q = _rmsnorm(jnp.stack([q1, q2], axis=2).astype(f32), qn_w) * (dk ** -0.5)
    k = _rmsnorm(jnp.stack([k1, k2], axis=2).astype(f32), kn_w)
    q = q.transpose(0, 3, 2, 1, 4)
    k = k.transpose(0, 3, 2, 1, 4)
    vf = v.astype(f32).transpose(0, 2, 1, 3)
    slopes = jnp.asarray(2.0 ** (-8.0 * np.arange(1, H + 1) / H), dtype=f32)
    kpos = jnp.arange(S)
    kchunk = kpos // CHUNK

    def block(j):
        start = j * Q_BLOCK
        qb = lax.dynamic_slice_in_dim(q, start, Q_BLOCK, axis=3)
        qpos = start + jnp.arange(Q_BLOCK)
        s = jnp.einsum('bhmqd,bhmkd->bhmqk', qb, k)
        dist = jnp.abs(qpos[:, None] - kpos[None, :]).astype(f32)
        mask = kchunk[None, :] <= (qpos // CHUNK)[:, None]
        s = jnp.where(mask, s - (slopes[:, None, None] * dist)[None, :, None], -jnp.inf)
        p = jax.nn.softmax(s, axis=-1)
        a = p[:, :, 0] - lam * p[:, :, 1]
        return jnp.einsum('bhqk,bhkd->bhqd', a, vf)

    o = lax.map(block, jnp.arange(S // Q_BLOCK))
    o = o.transpose(1, 0, 3, 2, 4).reshape(B, S, H, dv)
    o = _rmsnorm(o, subln_w) * (1.0 - lam_init)
    return o.reshape(B, S, H * dv).astype(v.dtype)


def _hgrn2(q, f_pre, i, g, lb, gnorm_w):
    B, S, H, dk = q.shape
    dv = i.shape[-1]
    n = S // CHUNK
    f32 = jnp.float32
    qf = jax.nn.silu(q.astype(f32))
    lb = lb.astype(f32).reshape(H, dk)
    logf = jnp.logaddexp(jnp.log(lb), jnp.log1p(-lb) + jax.nn.log_sigmoid(f_pre.astype(f32)))
    kf = -jnp.expm1(logf)
    vf = i.astype(f32)

    def to_chunks(t):
        return t.reshape(B, n, CHUNK, H, t.shape[-1]).transpose(1, 0, 3, 2, 4)

    causal = jnp.tril(jnp.ones((CHUNK, CHUNK), dtype=bool))

    def step(state, inp):
        qc, kc, vc, lfc = inp
        b = jnp.cumsum(lfc, axis=2)
        o_inter = jnp.einsum('bhtd,bhde->bhte', qc * jnp.exp(b), state)
        diff = b[:, :, :, None, :] - b[:, :, None, :, :]
        dec = jnp.exp(jnp.where(causal[:, :, None], diff, -jnp.inf))
        att = jnp.einsum('bhtd,bhsd,bhtsd->bhts', qc, kc, dec)
        o_intra = jnp.einsum('bhts,bhse->bhte', att, vc)
        b_last = b[:, :, -1:, :]
        state = (jnp.exp(b_last[:, :, 0, :])[..., None] * state
                 + jnp.einsum('bhsd,bhse->bhde', kc * jnp.exp(b_last - b), vc))
        return state, o_inter + o_intra

    s0 = jnp.zeros((B, H, dk, dv), f32)
    _, o = lax.scan(step, s0, (to_chunks(qf), to_chunks(kf), to_chunks(vf), to_chunks(logf)))
    o = o.transpose(1, 0, 3, 2, 4).reshape(B, S, H, dv)
    o = _rmsnorm(o, gnorm_w) * jax.nn.silu(g.astype(f32))
    return o.reshape(B, S, H * dv).astype(g.dtype)


def _mlstm(q, k, v, o_pre, i_pre, f_pre, norm_w):
    B, S, H, dk = q.shape
    dv = v.shape[-1]
    n = S // CHUNK
    f32 = jnp.float32
    qf = q.astype(f32)
    kf = k.astype(f32) * (dk ** -0.5)
    vf = v.astype(f32)
    ig = i_pre.astype(f32)
    lf = jax.nn.log_sigmoid(f_pre.astype(f32))

    def to_chunks(t):
        return t.reshape(B, n, CHUNK, H, t.shape[-1]).transpose(1, 0, 3, 2, 4)

    def gate_chunks(t):
        return t.reshape(B, n, CHUNK, H).transpose(1, 0, 3, 2)

    causal = jnp.tril(jnp.ones((CHUNK, CHUNK), dtype=bool))

    def step(carry, inp):
        C, nv, m = carry
        qc, kc, vc, igc, lfc = inp
        b = jnp.cumsum(lfc, axis=-1)
        log_d = jnp.where(causal, b[..., :, None] - b[..., None, :] + igc[..., None, :], -jnp.inf)
        log_inter = b + m[..., None]
        m_t = jnp.maximum(log_inter, jnp.max(log_d, axis=-1))
        w_intra = jnp.exp(log_d - m_t[..., None]) * jnp.einsum('bhtd,bhsd->bhts', qc, kc)
        w_inter = jnp.exp(log_inter - m_t)
        num = (w_inter[..., None] * jnp.einsum('bhtd,bhde->bhte', qc, C)
               + jnp.einsum('bhts,bhse->bhte', w_intra, vc))
        dot = w_inter * jnp.einsum('bhtd,bhd->bht', qc, nv) + jnp.sum(w_intra, axis=-1)
        h = num / jnp.maximum(jnp.abs(dot), jnp.exp(-m_t))[..., None]
        g = b[..., -1]
        log_w = g[..., None] - b + igc
        m_new = jnp.maximum(g + m, jnp.max(log_w, axis=-1))
        w_s = jnp.exp(log_w - m_new[..., None])
        decay = jnp.exp(g + m - m_new)
        C = decay[..., None, None] * C + jnp.einsum('bhs,bhsd,bhse->bhde', w_s, kc, vc)
        nv = decay[..., None] * nv + jnp.einsum('bhs,bhsd->bhd', w_s, kc)
        return (C, nv, m_new), h

    init = (jnp.zeros((B, H, dk, dv), f32), jnp.zeros((B, H, dk), f32), jnp.zeros((B, H), f32))
    _, h = lax.scan(step, init, (to_chunks(qf), to_chunks(kf), to_chunks(vf),
                                 gate_chunks(ig), gate_chunks(lf)))
    h = h.transpose(1, 0, 3, 2, 4).reshape(B, S, H, dv)
    h = _rmsnorm(h, norm_w) * jax.nn.sigmoid(o_pre.astype(f32))
    return h.reshape(B, S, H * dv).astype(v.dtype)


def _mixer(h, w_in, conv_w, conv_b, qn_w, kn_w, lq1, lk1, lq2, lk2, subln_w, lam_init,
           lb, gnorm_w, ib, fb, cnorm_w, w_branch, w_out):
    B, S, _ = h.shape
    f32 = jnp.float32
    parts = dict(zip(COL_NAMES, jnp.split(w_in, COL_OFFSETS, axis=1)))

    def proj(name):
        return h @ parts[name]

    def heads(t, nh):
        return t.reshape(B, S, nh, -1)

    lam = (jnp.exp(jnp.sum(lq1.astype(f32) * lk1.astype(f32)))
           - jnp.exp(jnp.sum(lq2.astype(f32) * lk2.astype(f32))) + lam_init)
    y_a = _diff_attention(heads(proj('a_q1'), DA_HEADS), heads(proj('a_q2'), DA_HEADS),
                          heads(proj('a_k1'), DA_HEADS), heads(proj('a_k2'), DA_HEADS),
                          heads(proj('a_v'), DA_HEADS), lam, lam_init, qn_w, kn_w, subln_w)
    y_b = _hgrn2(heads(proj('b_q'), HG_HEADS), heads(proj('b_f'), HG_HEADS),
                 heads(proj('b_i'), HG_HEADS), heads(proj('b_g'), HG_HEADS), lb, gnorm_w)
    qk = jax.nn.silu(_causal_conv(proj('c_qk'), conv_w, conv_b))
    c_q, c_k = jnp.split(qk, 2, axis=-1)
    y_c = _mlstm(heads(c_q, ML_HEADS), heads(c_k, ML_HEADS), heads(proj('c_v'), ML_HEADS),
                 heads(proj('c_o'), ML_HEADS), proj('c_i') + ib, proj('c_f') + fb, cnorm_w)
    gates = jax.nn.sigmoid(proj('gate')).reshape(B, S, N_BRANCH, D_MODEL)
    merged = (gates[:, :, 0] * (y_a @ w_branch[0])
              + gates[:, :, 1] * (y_b @ w_branch[1])
              + gates[:, :, 2] * (y_c @ w_branch[2]))
    return merged @ w_out


def _moe(h, router_w, router_b, w1, w3, w2):
    f32 = jnp.float32
    logits = (h @ router_w).astype(f32) + router_b.astype(f32)
    probs = jax.nn.softmax(logits, axis=-1)
    top_p, top_i = lax.top_k(probs, TOP_K)
    top_p = top_p / jnp.sum(top_p, axis=-1, keepdims=True)
    combine = jnp.sum(jax.nn.one_hot(top_i, N_EXPERTS, dtype=f32) * top_p[..., None], axis=-2)
    out = jnp.zeros_like(h)
    for e in range(N_EXPERTS):
        out = out + combine[..., e:e + 1].astype(h.dtype) * _swiglu(h, w1[e], w3[e], w2[e])
    return out


def setup_inputs(seed: int = 0) -> dict:
    key = jax.random.key(seed)
    ks = jax.random.split(key, 32)
    f32 = jnp.float32
    D = D_MODEL

    def nrm(k, shape, scale):
        return scale * jax.random.normal(k, shape, f32)

    def gain(k, shape):
        return 1.0 + 0.02 * jax.random.normal(k, shape, f32)

    return {
        'x': nrm(ks[0], (BATCH, SEQ, D), 1.0),
        'c': nrm(ks[1], (BATCH, D), 1.0),
        'w_mod': nrm(ks[2], (DEPTH, D, 6 * D), 0.5 * D ** -0.5),
        'b_mod': nrm(ks[3], (DEPTH, 6 * D), 0.02),
        'norm1_w': gain(ks[4], (DEPTH, D)),
        'norm2_w': gain(ks[5], (DEPTH, D)),
        'w_in': nrm(ks[6], (DEPTH, D, D_IN), D ** -0.5),
        'c_conv_w': nrm(ks[7], (DEPTH, ML_CONV, 2 * ML_HEADS * ML_DK), ML_CONV ** -0.5),
        'c_conv_b': nrm(ks[8], (DEPTH, 2 * ML_HEADS * ML_DK), 0.02),
        'a_qnorm_w': gain(ks[9], (DEPTH, DA_DK)),
        'a_knorm_w': gain(ks[10], (DEPTH, DA_DK)),
        'a_lambda_q1': nrm(ks[11], (DEPTH, DA_DK), 0.1),
        'a_lambda_k1': nrm(ks[12], (DEPTH, DA_DK), 0.1),
        'a_lambda_q2': nrm(ks[13], (DEPTH, DA_DK), 0.1),
        'a_lambda_k2': nrm(ks[14], (DEPTH, DA_DK), 0.1),
        'a_subln_w': gain(ks[15], (DEPTH, DA_DV)),
        'b_lb_logits': nrm(ks[16], (DEPTH, HG_HEADS * HG_DK), 1.0),
        'b_gnorm_w': gain(ks[17], (DEPTH, HG_DV)),
        'c_igate_b': nrm(ks[18], (DEPTH, ML_HEADS), 0.1),
        'c_fgate_b': jnp.linspace(3.0, 6.0, ML_HEADS, dtype=f32)[None, :] + nrm(ks[19], (DEPTH, ML_HEADS), 0.1),
        'c_norm_w': gain(ks[20], (DEPTH, ML_DV)),
        'w_branch': nrm(ks[21], (DEPTH, N_BRANCH, BRANCH_W, D), BRANCH_W ** -0.5),
        'w_out': nrm(ks[22], (DEPTH, D, D), D ** -0.5),
        'ffn_w1': nrm(ks[23], (N_DENSE, D, D_FF), D ** -0.5),
        'ffn_w3': nrm(ks[24], (N_DENSE, D, D_FF), D ** -0.5),
        'ffn_w2': nrm(ks[25], (N_DENSE, D_FF, D), D_FF ** -0.5),
        'moe_router_w': nrm(ks[26], (N_MOE, D, N_EXPERTS), D ** -0.5),
        'moe_router_b': nrm(ks[27], (N_MOE, N_EXPERTS), 0.01),
        'moe_w1': nrm(ks[28], (N_MOE, N_EXPERTS, D, D_FF), D ** -0.5),
        'moe_w3': nrm(ks[29], (N_MOE, N_EXPERTS, D, D_FF), D ** -0.5),
        'moe_w2': nrm(ks[30], (N_MOE, N_EXPERTS, D_FF, D), D_FF ** -0.5),
    }


def reference(x, c, w_mod, b_mod, norm1_w, norm2_w, w_in, c_conv_w, c_conv_b,
              a_qnorm_w, a_knorm_w, a_lambda_q1, a_lambda_k1, a_lambda_q2, a_lambda_k2,
              a_subln_w, b_lb_logits, b_gnorm_w, c_igate_b, c_fgate_b, c_norm_w,
              w_branch, w_out, ffn_w1, ffn_w3, ffn_w2,
              moe_router_w, moe_router_b, moe_w1, moe_w3, moe_w2):
    lb_all = jnp.cumsum(jax.nn.softmax(b_lb_logits.astype(jnp.float32), axis=0), axis=0)
    lb_all = lb_all - lb_all[:1]
    cond = jax.nn.silu(c)
    for l in range(DEPTH):
        mod = cond @ w_mod[l] + b_mod[l]
        sh1, sc1, g1, sh2, sc2, g2 = jnp.split(mod, 6, axis=-1)
        lam_init = 0.8 - 0.6 * math.exp(-0.3 * l)
        h = _modulate(_rmsnorm(x, norm1_w[l]), sh1, sc1)
        y = _mixer(h, w_in[l], c_conv_w[l], c_conv_b[l], a_qnorm_w[l], a_knorm_w[l],
                   a_lambda_q1[l], a_lambda_k1[l], a_lambda_q2[l], a_lambda_k2[l],
                   a_subln_w[l], lam_init, lb_all[l], b_gnorm_w[l],
                   c_igate_b[l], c_fgate_b[l], c_norm_w[l], w_branch[l], w_out[l])
        x = x + g1[:, None, :] * y
        h = _modulate(_rmsnorm(x, norm2_w[l]), sh2, sc2)
        if l % 2 == 0:
            i = l // 2
            y = _swiglu(h, ffn_w1[i], ffn_w3[i], ffn_w2[i])
        else:
            i = l // 2
            y = _moe(h, moe_router_w[i], moe_router_b[i], moe_w1[i], moe_w3[i], moe_w2[i])
        x = x + g2[:, None, :] * y
    return x
```

```cpp
#include <hip/hip_runtime.h>
#include <cstdio>
#include <cstdint>
#include <cmath>

#ifndef MK_PER_PHASE
#define MK_PER_PHASE 0
#endif

namespace pg8 {
#define PG8_LAS __attribute__((address_space(3)))
typedef unsigned short bf16_t;
typedef short bf16x8 __attribute__((ext_vector_type(8)));
typedef float f32x4 __attribute__((ext_vector_type(4)));
typedef unsigned u32x4 __attribute__((ext_vector_type(4)));
typedef int i32x4 __attribute__((ext_vector_type(4)));
template <class T> __device__ __forceinline__ T vzero4() { T z; z[0] = 0; z[1] = 0; z[2] = 0; z[3] = 0; return z; }
constexpr int BM = 256, BK = 64, HALF = 128, HTB = HALF * BK * 2  , STAGE_BYTES = 8 * HTB, NXCD = 8, WGM = 4, SCL_OFF = 147456  ;

__host__ __device__ __forceinline__ int lds_byte(int r, int c) { const int st = (r >> 4) * 2 + (c >> 5), rr = r & 15, cc = c & 31, ob = rr * 64 + cc * 2; return st * 1024 + (ob ^ (((ob >> 9) & 1) << 5)); }
__host__ __device__ __forceinline__ void stage_rc(int b, int& R, int& C) { const int st = b / 1024, sb = b % 1024, swz = sb ^ (((sb >> 9) & 1) << 5); R = (st >> 1) * 16 + swz / 64; C = (st & 1) * 32 + (swz % 64) / 2; }
__host__ __device__ __forceinline__ int perm32(int rho) { const int n = rho >> 4, i = rho & 15; return 8 * (i >> 2) + 4 * n + (i & 3); }

struct Unit { int pm, pn; };
struct Gemm { const bf16_t* A; const bf16_t* Bt; int M, N, K; };

struct StaticOrder {
    int nM, nN, nwg, G, c;
    __host__ __device__ void init(int M, int N, int G_, int c_) { nM = M / BM; nN = N / BM; nwg = nM * nN; G = G_; c = c_; }
    __host__ __device__ bool next(int i, Unit& u) const {
        const long L = (long)i * G + c; if (L >= nwg) return false;
        int wgid = (int)L; { const int q = nwg / NXCD, r = nwg % NXCD, xcd = wgid % NXCD, off = wgid / NXCD; wgid = (xcd < r ? xcd * (q + 1) : r * (q + 1) + (xcd - r) * q) + off; }
        const int nig = WGM * nN, gid = wgid / nig, fm = gid * WGM, gsz = (nM - fm) < WGM ? (nM - fm) : WGM;
        u.pm = fm + ((wgid % nig) % gsz); u.pn = (wgid % nig) / gsz; return true;
    }
    __device__ __forceinline__ void a_ready(const Unit&) const {}
    __device__ __forceinline__ void done(const Unit&) const {}
};

__device__ __forceinline__ unsigned cvt_pk_bf16(float lo, float hi) { unsigned r; asm volatile("v_cvt_pk_bf16_f32 %0, %1, %2" : "=v"(r) : "v"(lo), "v"(hi)); return r; }
typedef float f32x2 __attribute__((ext_vector_type(2)));
template <class Epi, class Sched, bool ALIGN_EPI = false, bool SP2 = false, bool GATHER = false>
__device__ __forceinline__ void gemm_phase(PG8_LAS unsigned char* lds, const Gemm g, const Sched& S, const Epi& E, int tid_in, const PG8_LAS unsigned short* toks = nullptr) {
    static_assert(!GATHER || SP2, "the gather variant is written for the SP2 loop");
    int tid_l = tid_in; asm volatile("" : "+v"(tid_l));
    const int tid = tid_l, wid = __builtin_amdgcn_readfirstlane(tid >> 6), lane = tid & 63, wr = wid >> 2, wc = wid & 3, fr = lane & 15, fq = lane >> 4;
    const int K = g.K, nt = K / BK;
    unsigned voffA[2], voffB[2], gC2[2]; int gR[2];
#pragma unroll
    for (int i = 0; i < 2; ++i) { int R, C; stage_rc(tid * 16 + i * 8192, R, C); const int Rb = Epi::PERM ? ((R & ~31) + perm32(R & 31)) : R;
        voffA[i] = (unsigned)(R * K + C) * 2u; voffB[i] = (unsigned)(Rb * K + C) * 2u; gR[i] = R; gC2[i] = (unsigned)C * 2u; }
    const size_t kstep = (size_t)(BK * 2);
    const size_t hstep = (size_t)HALF * K * 2;
    const size_t tstep = 2 * hstep;
    const unsigned ldsw = (unsigned)wid * 1024u;
    const int aoff = lds_byte(wr * 64 + fr, fq * 8), boff = lds_byte(wc * 32 + fr, fq * 8);
#define PG8_SA(b, h) (((b) * 2 + (h)) * HTB)
#define PG8_SB(b, h) ((4 + (b) * 2 + (h)) * HTB)
#define PG8_STAGE(bufoff, gbase, voff) do { _Pragma("unroll") for (int _i = 0; _i < 2; ++_i) \
        __builtin_amdgcn_global_load_lds((const unsigned*)((const char*)(gbase) + (voff)[_i]), (PG8_LAS unsigned*)(lds + (bufoff) + ldsw + _i * 8192), 16, 0, 0); } while (0)
#define PG8_STAGE_A(bufoff, gbase, h, nx) do { if constexpr (GATHER) { unsigned s_[2] = { (nx) ? offN[h][0] : offC[h][0], (nx) ? offN[h][1] : offC[h][1] }; PG8_STAGE(bufoff, gbase, s_); } \
        else { PG8_STAGE(bufoff, (gbase) + (h) * hstep, voffA); } } while (0)
#define PG8_GOFF(dst, u) do { int tl_ = fr + 16 * fq; asm volatile("" : "+v"(tl_)); int R_, C_; stage_rc((wid * 64 + tl_) * 16, R_, C_);        \
        _Pragma("unroll") for (int h_ = 0; h_ < 2; ++h_) _Pragma("unroll") for (int i_ = 0; i_ < 2; ++i_) \
        dst[h_][i_] = (unsigned)toks[(u) * 256 + h_ * 128 + R_ + 64 * i_] * (unsigned)(K * 2) + (unsigned)C_ * 2u; } while (0)
#define PG8_LDA(dst, b, h) do { _Pragma("unroll") for (int m = 0; m < 4; ++m) _Pragma("unroll") for (int k = 0; k < 2; ++k) dst[m][k] = *(const PG8_LAS bf16x8*)(lds + PG8_SA(b, h) + aoff + m * 2048 + k * 1024); } while (0)
#define PG8_LDB(dst, b, h) do { _Pragma("unroll") for (int n = 0; n < 2; ++n) _Pragma("unroll") for (int k = 0; k < 2; ++k) dst[n][k] = *(const PG8_LAS bf16x8*)(lds + PG8_SB(b, h) + boff + n * 2048 + k * 1024); } while (0)
#define PG8_MMA(ai, bj, At, Bt) do { __builtin_amdgcn_s_setprio(1); _Pragma("unroll") for (int m = 0; m < 4; ++m) _Pragma("unroll") for (int n = 0; n < 2; ++n) _Pragma("unroll") for (int k = 0; k < 2; ++k) \
        { if constexpr (Epi::I8) acc[ai][bj][m][n] = __builtin_amdgcn_mfma_i32_16x16x64_i8((i32x4)Bt[n][k], (i32x4)At[m][k], acc[ai][bj][m][n], 0, 0, 0); \
          else acc[ai][bj][m][n] = __builtin_amdgcn_mfma_f32_16x16x32_bf16(Bt[n][k], At[m][k], acc[ai][bj][m][n], 0, 0, 0); } __builtin_amdgcn_s_setprio(0); } while (0)
#define PG8_SCL(u_, par) do { if constexpr (Epi::I8) { int tl_ = fr + 16 * fq; asm volatile("" : "+v"(tl_)); \
        const float* gp_ = wid < 4 ? E.sa + (size_t)(u_).pm * BM + wid * 64 + tl_ : E.cm + (size_t)(u_).pn * BM + (wid - 4) * 64 + tl_; \
        __builtin_amdgcn_global_load_lds((const unsigned*)gp_, (PG8_LAS unsigned*)(lds + SCL_OFF + (par) * 2048 + wid * 256), 4, 0, 0); } } while (0)
#define PG8_WAIT_V(n) asm volatile("s_waitcnt vmcnt(" #n ")" ::: "memory")
#define PG8_WAIT_L(n) asm volatile("s_waitcnt lgkmcnt(" #n ")" ::: "memory")
#define PG8_BAR __builtin_amdgcn_s_barrier()
#define PG8_SCHED __builtin_amdgcn_sched_barrier(0)
    Unit cur, nxt; int ui = 0;
    if (!S.next(0, cur)) return;
    typedef typename Epi::acc_t acc_t;
    acc_t acc[2][2][4][2];
#pragma unroll
    for (int a = 0; a < 2; ++a)
#pragma unroll
        for (int b = 0; b < 2; ++b)
#pragma unroll
            for (int m = 0; m < 4; ++m)
#pragma unroll
                for (int n = 0; n < 2; ++n) acc[a][b][m][n] = vzero4<acc_t>();
    bf16x8 At[4][2], B0[2][2], B1[2][2];
    const char* cA = (const char*)g.A + (GATHER ? (size_t)0 : (size_t)cur.pm * tstep); const char* cB = (const char*)g.Bt + (size_t)cur.pn * tstep;
    unsigned offC[2][2], offN[2][2];
    if constexpr (GATHER) { PG8_GOFF(offC, 0); PG8_GOFF(offN, 0); } else { offC[0][0] = offC[0][1] = offC[1][0] = offC[1][1] = 0u; offN[0][0] = offN[0][1] = offN[1][0] = offN[1][1] = 0u; }
    S.a_ready(cur);
    PG8_SCL(cur, 0);
    if constexpr (SP2) {
        PG8_STAGE(PG8_SB(0, 0), cB, voffB); PG8_STAGE(PG8_SB(0, 1), cB + hstep, voffB); PG8_STAGE_A(PG8_SA(0, 0), cA, 0, false); PG8_STAGE_A(PG8_SA(0, 1), cA, 1, false);
        if (wr == 1) PG8_BAR;
        PG8_WAIT_V(2); PG8_BAR;
        PG8_STAGE(PG8_SB(1, 0), cB + kstep, voffB); PG8_STAGE_A(PG8_SA(1, 0), cA + kstep, 0, false); PG8_STAGE(PG8_SB(1, 1), cB + hstep + kstep, voffB);
        PG8_WAIT_V(6); PG8_BAR;
    } else {
        PG8_STAGE(PG8_SB(0, 0), cB, voffB); PG8_STAGE(PG8_SA(0, 0), cA, voffA); PG8_STAGE(PG8_SB(0, 1), cB + hstep, voffB); PG8_STAGE(PG8_SA(0, 1), cA + hstep, voffA);
        if (wr == 1) PG8_BAR;
        PG8_WAIT_V(4); PG8_BAR;
        PG8_STAGE(PG8_SB(1, 0), cB + kstep, voffB); PG8_STAGE(PG8_SA(1, 0), cA + kstep, voffA); PG8_STAGE(PG8_SB(1, 1), cB + hstep + kstep, voffB);
        PG8_WAIT_V(6); PG8_BAR;
    }
    for (;;) {
        const bool has_next = S.next(ui + 1, nxt);
        if constexpr (GATHER) { if (has_next) PG8_GOFF(offN, ui + 1); else { offN[0][0] = offC[0][0]; offN[0][1] = offC[0][1]; offN[1][0] = offC[1][0]; offN[1][1] = offC[1][1]; } }
        const char* nA = (has_next && !GATHER) ? (const char*)g.A + (size_t)nxt.pm * tstep : cA; const char* nB = has_next ? (const char*)g.Bt + (size_t)nxt.pn * tstep : cB;
        for (int t = 0; t < nt; t += 2) {
            const bool last = (t == nt - 2);
            const char* a1 = cA + (size_t)(t + 1) * kstep;
            const char* a2 = last ? nA : cA + (size_t)(t + 2) * kstep; const char* b2 = last ? nB : cB + (size_t)(t + 2) * kstep;
            const char* a3 = a2 + kstep; const char* b3 = b2 + kstep;
            if (last && has_next) { S.a_ready(nxt); PG8_SCL(nxt, (ui + 1) & 1); }
            if constexpr (SP2) {
            PG8_LDB(B0, 0, 0); PG8_LDB(B1, 0, 1); PG8_SCHED; PG8_LDA(At, 0, 0); PG8_STAGE_A(PG8_SA(1, 1), a1, 1, false);
            PG8_WAIT_V(8); PG8_WAIT_L(0); PG8_BAR; PG8_MMA(0, 0, At, B0); PG8_MMA(0, 1, At, B1); PG8_BAR; PG8_SCHED;
            PG8_LDA(At, 0, 1); PG8_STAGE(PG8_SB(0, 0), b2, voffB); PG8_STAGE(PG8_SB(0, 1), b2 + hstep, voffB); PG8_STAGE_A(PG8_SA(0, 0), a2, 0, last);
            PG8_WAIT_V(8); PG8_WAIT_L(0); PG8_BAR; PG8_MMA(1, 0, At, B0); PG8_MMA(1, 1, At, B1); PG8_BAR; PG8_SCHED;
            PG8_LDB(B0, 1, 0); PG8_LDB(B1, 1, 1); PG8_SCHED; PG8_LDA(At, 1, 0); PG8_STAGE_A(PG8_SA(0, 1), a2, 1, last);
            PG8_WAIT_V(8); PG8_WAIT_L(0); PG8_BAR; PG8_MMA(0, 0, At, B0); PG8_MMA(0, 1, At, B1); PG8_BAR; PG8_SCHED;
            PG8_LDA(At, 1, 1); PG8_STAGE(PG8_SB(1, 0), b3, voffB); PG8_STAGE(PG8_SB(1, 1), b3 + hstep, voffB); PG8_STAGE_A(PG8_SA(1, 0), a3, 0, last);
            PG8_WAIT_V(8); PG8_WAIT_L(0); PG8_BAR; PG8_MMA(1, 0, At, B0); PG8_MMA(1, 1, At, B1); PG8_BAR; PG8_SCHED;
            } else {
            PG8_LDB(B0, 0, 0); PG8_SCHED; PG8_LDA(At, 0, 0); PG8_STAGE(PG8_SA(1, 1), a1 + hstep, voffA);
            PG8_WAIT_L(8); PG8_BAR; PG8_WAIT_L(0); PG8_MMA(0, 0, At, B0); PG8_BAR; PG8_SCHED;
            PG8_LDB(B1, 0, 1); PG8_STAGE(PG8_SB(0, 0), b2, voffB);
            PG8_BAR; PG8_WAIT_L(0); PG8_MMA(0, 1, At, B1); PG8_BAR;
            PG8_LDA(At, 0, 1); PG8_STAGE(PG8_SA(0, 0), a2, voffA);
            PG8_BAR; PG8_WAIT_L(0); PG8_MMA(1, 0, At, B0); PG8_BAR; PG8_SCHED;
            PG8_STAGE(PG8_SB(0, 1), b2 + hstep, voffB);
            PG8_WAIT_V(6); PG8_BAR; PG8_MMA(1, 1, At, B1); PG8_BAR;
            PG8_LDB(B0, 1, 0); PG8_SCHED; PG8_LDA(At, 1, 0); PG8_STAGE(PG8_SA(0, 1), a2 + hstep, voffA);
            PG8_WAIT_L(8); PG8_BAR; PG8_WAIT_L(0); PG8_MMA(0, 0, At, B0); PG8_BAR; PG8_SCHED;
            PG8_LDB(B1, 1, 1); PG8_STAGE(PG8_SB(1, 0), b3, voffB);
            PG8_BAR; PG8_WAIT_L(0); PG8_MMA(0, 1, At, B1); PG8_BAR;
            PG8_LDA(At, 1, 1); PG8_STAGE(PG8_SA(1, 0), a3, voffA);
            PG8_BAR; PG8_WAIT_L(0); PG8_MMA(1, 0, At, B0); PG8_BAR; PG8_SCHED;
            PG8_STAGE(PG8_SB(1, 1), b3 + hstep, voffB);
            PG8_WAIT_V(6); PG8_BAR; PG8_MMA(1, 1, At, B1); PG8_BAR;
            }
        }
        if constexpr (ALIGN_EPI) { if (wr == 0) PG8_BAR; }
        if constexpr (!Epi::AFTER_DRAIN) { if constexpr (Epi::I8) E(acc, cur, wr, wc, fr, fq, (const PG8_LAS float*)(lds + SCL_OFF + (ui & 1) * 2048)); else E(acc, cur, wr, wc, fr, fq); S.done(cur); }
        if (!has_next) break;
        if (!E.keep_acc(cur)) {
#pragma unroll
        for (int a = 0; a < 2; ++a)
#pragma unroll
            for (int b = 0; b < 2; ++b)
#pragma unroll
                for (int m = 0; m < 4; ++m)
#pragma unroll
                    for (int n = 0; n < 2; ++n) acc[a][b][m][n] = vzero4<acc_t>();
        }
        cur = nxt; cA = nA; cB = nB; ++ui;
        if constexpr (GATHER) { offC[0][0] = offN[0][0]; offC[0][1] = offN[0][1]; offC[1][0] = offN[1][0]; offC[1][1] = offN[1][1]; }
        if constexpr (ALIGN_EPI) { if (wr == 1) PG8_BAR; }
    }
    PG8_WAIT_V(0);
    if constexpr (!ALIGN_EPI) { if (wr == 0) PG8_BAR; }
    PG8_BAR;
    if constexpr (Epi::AFTER_DRAIN) { E.fused(acc, cur, wr, wc, fr, fq, lds, wid, lane); S.done(cur); }
#undef PG8_SA
#undef PG8_SB
#undef PG8_STAGE
#undef PG8_STAGE_A
#undef PG8_GOFF
#undef PG8_LDA
#undef PG8_LDB
#undef PG8_MMA
#undef PG8_SCL
#undef PG8_WAIT_V
#undef PG8_WAIT_L
#undef PG8_BAR
#undef PG8_SCHED
}
}

#define GAS __attribute__((address_space(1)))
#define LAS __attribute__((address_space(3)))
typedef unsigned short bf16;
typedef unsigned v4u __attribute__((ext_vector_type(4)));
typedef unsigned v2u __attribute__((ext_vector_type(2)));
typedef float f32x4 __attribute__((ext_vector_type(4)));
typedef float f32x2 __attribute__((ext_vector_type(2)));
typedef float f32x16 __attribute__((ext_vector_type(16)));
typedef short bf16x8 __attribute__((ext_vector_type(8)));
typedef short s16x4 __attribute__((ext_vector_type(4)));
typedef GAS unsigned gu32;
#define RLX_AGENT __ATOMIC_RELAXED, __HIP_MEMORY_SCOPE_AGENT
#define LDS_WAIT() asm volatile("s_waitcnt lgkmcnt(0)" ::: "memory")
#define VM_WAIT() asm volatile("s_waitcnt vmcnt(0)" ::: "memory")
__device__ __forceinline__ unsigned f2bf(float f) { unsigned u = __builtin_bit_cast(unsigned, f); return (u + 0x7fffu + ((u >> 16) & 1u)) >> 16; }
typedef __bf16 bf16x2_t __attribute__((ext_vector_type(2)));
__device__ __forceinline__ unsigned pk2(float lo, float hi) { f32x2 v = {lo, hi}; bf16x2_t b = __builtin_convertvector(v, bf16x2_t); return __builtin_bit_cast(unsigned, b); }
__device__ __forceinline__ unsigned fbits(float f) { return __builtin_bit_cast(unsigned, f); }
__device__ __forceinline__ float bf2f(unsigned b) { return __builtin_bit_cast(float, b << 16); }
__device__ __forceinline__ float bflo(unsigned w) { return __builtin_bit_cast(float, w << 16); }
__device__ __forceinline__ float bfhi(unsigned w) { return __builtin_bit_cast(float, w & 0xffff0000u); }
__device__ __forceinline__ float fexp2(float x) { return __builtin_amdgcn_exp2f(x); }
__device__ __forceinline__ float fexp(float x) { return __builtin_amdgcn_exp2f(x * 1.4426950408889634f); }
__device__ __forceinline__ float flog(float x) { return __builtin_amdgcn_logf(x) * 0.6931471805599453f; }
__device__ __forceinline__ float frcp(float x) { return __builtin_amdgcn_rcpf(x); }
__device__ __forceinline__ float fsigmoid(float x) { return frcp(1.f + fexp(-x)); }
__device__ __forceinline__ float fsilu(float x) { return x * fsigmoid(x); }
__device__ __forceinline__ int lane_now() { int x; asm volatile("v_mbcnt_lo_u32_b32 %0, -1, 0\n\tv_mbcnt_hi_u32_b32 %0, -1, %0" : "=v"(x)); return x; }
template <int CTRL, int ROWMASK = 0xF> __device__ __forceinline__ float dppf(float old, float v) { return __builtin_bit_cast(float, __builtin_amdgcn_update_dpp(__builtin_bit_cast(int, old), __builtin_bit_cast(int, v), CTRL, ROWMASK, 0xF, false)); }
__device__ __forceinline__ float wave_sum(float v) {
    v += dppf<0xB1>(0.f, v); v += dppf<0x4E>(0.f, v); v += dppf<0x141>(0.f, v); v += dppf<0x140>(0.f, v);
    v += dppf<0x142, 0xA>(0.f, v); v += dppf<0x143, 0xC>(0.f, v);
    return __builtin_bit_cast(float, __builtin_amdgcn_readlane(__builtin_bit_cast(int, v), 63));
}
__device__ __forceinline__ float wave_max_nonneg(float v) {
    v = __builtin_fmaxf(v, dppf<0xB1>(0.f, v)); v = __builtin_fmaxf(v, dppf<0x4E>(0.f, v)); v = __builtin_fmaxf(v, dppf<0x141>(0.f, v)); v = __builtin_fmaxf(v, dppf<0x140>(0.f, v));
    v = __builtin_fmaxf(v, dppf<0x142, 0xA>(0.f, v)); v = __builtin_fmaxf(v, dppf<0x143, 0xC>(0.f, v));
    return __builtin_bit_cast(float, __builtin_amdgcn_readlane(__builtin_bit_cast(int, v), 63));
}
#define XB_TMO      128
#define XB_XCNT(j)  (256  + 64 * (j))
#define XB_XSUB(j)  (1280 + 64 * (j))
#define XB_XGEN(j)  (2304 + 64 * (j))
#define XB_TOP      3328
#define XB_TOPGEN   3392
#define XCD_BAR_WORDS 3456
#define XB_SPIN_CAP (1u << 18)

__device__ __forceinline__ unsigned xb_ld(unsigned* p)              { return __hip_atomic_load(p, __ATOMIC_RELAXED, __HIP_MEMORY_SCOPE_AGENT); }
__device__ __forceinline__ unsigned xb_add(unsigned* p, unsigned v) { return __hip_atomic_fetch_add(p, v, __ATOMIC_RELAXED, __HIP_MEMORY_SCOPE_AGENT); }
__device__ __forceinline__ unsigned xb_xcc_id() { return (unsigned)__builtin_amdgcn_s_getreg((3 << 11) | 20) & 0xFu; }
#define XB_SPIN(cond, bar) do { unsigned _sp = 0; while (cond) { __builtin_amdgcn_s_sleep(1); \
    if ((++_sp & 255u) == 0u) { if (xb_ld(&(bar)[XB_TMO])) break; if (_sp > XB_SPIN_CAP) { atomicAdd(&(bar)[XB_TMO], 1u); break; } } } } while (0)

struct XcdBarrier {
    unsigned* bar; unsigned x;
    volatile LAS unsigned* st;
};

__device__ __forceinline__ XcdBarrier xcd_barrier_post(unsigned* bar, volatile LAS unsigned* st, bool t0) {
    XcdBarrier b; b.bar = bar; b.x = xb_xcc_id(); b.st = st;
    if (t0) (void)xb_add(&bar[XB_XCNT(b.x)], 1u);
    return b;
}
__device__ __forceinline__ void xcd_barrier_complete(unsigned* bar, unsigned x, unsigned& nloc, unsigned& nx) {
    const unsigned G = gridDim.x * gridDim.y * gridDim.z;
    unsigned sum, cnt, mine, sp = 0u;
    for (;;) {
        sum = 0u; cnt = 0u; mine = 0u;
#pragma unroll
        for (unsigned j = 0; j < 16; ++j) { const unsigned c = xb_ld(&bar[XB_XCNT(j)]); sum += c; cnt += (c > 0u) ? 1u : 0u; mine = (j == x) ? c : mine; }
        if (sum == G) break;
        __builtin_amdgcn_s_sleep(1);
        if ((++sp & 255u) == 0u) { if (xb_ld(&bar[XB_TMO])) break; if (sp > XB_SPIN_CAP) { atomicAdd(&bar[XB_TMO], 1u); break; } }
    }
    nloc = mine > 0u ? mine : 1u; nx = cnt > 0u ? cnt : 1u;
}

__device__ __forceinline__ void xcd_barrier(const XcdBarrier& b, bool t0) {
    asm volatile("s_waitcnt vmcnt(0)" ::: "memory");
    __syncthreads();
    if (t0) {
        unsigned* bar = b.bar;
        __builtin_amdgcn_s_waitcnt(0);
        unsigned nloc = b.st[0], nx = b.st[1];
        if (nloc == 0u) { xcd_barrier_complete(bar, b.x, nloc, nx); b.st[0] = nloc; b.st[1] = nx; }
        const unsigned old = xb_add(&bar[XB_XSUB(b.x)], 1u);
        const unsigned gen = old / nloc;
        if (old + 1u == (gen + 1u) * nloc) {
            __builtin_amdgcn_fence(__ATOMIC_RELEASE, "agent");
            asm volatile("s_waitcnt vmcnt(0)" ::: "memory");
            const unsigned og = xb_add(&bar[XB_TOP], 1u);
            const unsigned tg = og / nx;
            if (og + 1u == (tg + 1u) * nx) xb_add(&bar[XB_TOPGEN], 1u);
            else XB_SPIN(xb_ld(&bar[XB_TOPGEN]) == tg, bar);
            __builtin_amdgcn_fence(__ATOMIC_ACQUIRE, "agent");
            xb_add(&bar[XB_XGEN(b.x)], 1u);
            asm volatile("s_waitcnt vmcnt(0)" ::: "memory");
        } else {
            XB_SPIN(xb_ld(&bar[XB_XGEN(b.x)]) == gen, bar);
            __builtin_amdgcn_fence(__ATOMIC_ACQUIRE, "agent");
            asm volatile("s_waitcnt vmcnt(0)" ::: "memory");
        }
    }
    __syncthreads();
}

#ifndef I8_MOE
#define I8_MOE 1
#endif
#ifndef I8_DENSE
#define I8_DENSE 1
#endif
constexpr int NWAVES = 8, NTHR = 512;
constexpr int NB = 2, SEQ = 16384, DM = 1024, MTOK = NB * SEQ, DEPTH = 4;
constexpr int D_IN = 8712, PROJ_N = 5632  , WIN_ROWS = 8704  , NGATE0 = 5632, NGATE = 3072, DFF = 2816, NEXP = 8;
constexpr int C_AQ = 0, C_AK = 512, C_AV = 1024, C_BQ = 1536, C_BF = 2048, C_BI = 2560, C_BG = 3072, C_CQ = 3584, C_CK = 4096, C_CV = 4608, C_CO = 5120;
constexpr int MOE_ROWS = 2 * MTOK + NEXP * 256;
constexpr float NORM_EPS = 1e-6f;
constexpr size_t MiB = 1u << 20;
constexpr size_t WS_CTL = 0, CTL_ZERO_BYTES = 1 * MiB;
constexpr size_t WS_MOD = 1 * MiB;
constexpr size_t WS_META = 1 * MiB + 512 * 1024;
constexpr size_t WS_TOK = WS_META + 64 * 1024;
constexpr size_t WS_CIF = 2 * MiB;
constexpr size_t WS_RE = 3 * MiB;
constexpr size_t WS_RW = WS_RE + 128 * 1024;
constexpr size_t WS_POS = WS_RW + 256 * 1024;
constexpr size_t WS_WPOS = WS_POS + 256 * 1024;
constexpr size_t WS_STS = 4 * MiB;
constexpr size_t WS_STA = 20 * MiB;
constexpr size_t WS_STN = 20 * MiB + 256 * 1024;
constexpr size_t WS_SA = 20 * MiB + 512 * 1024;
constexpr size_t WS_SAP = 20 * MiB + 640 * 1024;
constexpr size_t WS_WIN = 22 * MiB;
constexpr size_t WS_WBR = 90 * MiB;
constexpr size_t WS_WOUT = 102 * MiB;
constexpr size_t WS_W13D = 110 * MiB;
constexpr size_t WS_W2D = 132 * MiB;
constexpr size_t WS_H = 144 * MiB;
constexpr size_t WS_PROJ = 208 * MiB;
constexpr size_t WS_GATE8 = 560 * MiB;
constexpr size_t WS_Y = 752 * MiB;
constexpr size_t WS_ATTO = 848 * MiB;
constexpr size_t WS_XB = 912 * MiB;
constexpr size_t WS_END = 976 * MiB;
constexpr size_t WS_U = WS_PROJ;
constexpr size_t WS_W13M = WS_PROJ + 364 * MiB;
constexpr size_t WS_W2M = WS_PROJ + 452 * MiB;
constexpr size_t WS_AS = WS_PROJ + 496 * MiB;
static_assert(WS_AS + (size_t)MOE_ROWS * 1024 * 2 <= WS_END && WS_U + (size_t)MOE_ROWS * DFF * 2 <= WS_W13M && WS_W13M + (size_t)8 * 5632 * 1024 * 2 <= WS_W2M && WS_W2M + (size_t)8 * 1024 * DFF * 2 <= WS_AS, "overlay map");
constexpr int CW_BAR = 4096;
constexpr int CW_QUEUE = 8192;
constexpr int CW_CNT = 16384;
constexpr int CW_CM = 32768;
constexpr int CM_W13D = CW_CM, CM_W13M = CW_CM + 2 * 5632, CM_WIN = CM_W13M + 16 * 5632  , CM_END = CM_WIN + DEPTH * WIN_ROWS;
static_assert((size_t)CM_END * 4 <= CTL_ZERO_BYTES, "CTL map");
constexpr int LDS_BYTES = 147456 + 4096;
constexpr int RING_BYTES = 131072, MISC_OFF = RING_BYTES + 320;
constexpr int TOK_LDS = RING_BYTES + 1024, TOK_UNITS = 23;
static_assert(TOK_LDS + TOK_UNITS * 512 <= 147456, "LDS map");

struct Ctx {
    const float *x, *c, *w_mod, *b_mod, *norm1_w, *norm2_w, *w_in, *conv_w, *conv_b, *qn_w, *kn_w, *lq1, *lk1, *lq2, *lk2, *subln_w, *lb_logits, *gnorm_w,
                *ig_b, *fg_b, *cnorm_w, *w_branch, *w_out, *ffn_w1, *ffn_w3, *ffn_w2, *router_w, *router_b, *moe_w1, *moe_w3, *moe_w2;
    float* out; unsigned char* ws;
};

namespace pg8 {
__device__ __forceinline__ unsigned pkbf(float lo, float hi) { return cvt_pk_bf16(lo, hi); }
struct EpiProj {
    static constexpr bool PERM = true, AFTER_DRAIN = false, I8 = true; typedef i32x4 acc_t; __device__ __forceinline__ bool keep_acc(const Unit&) const { return false; } bf16_t* O; const float* qnw; const float* knw; unsigned char* G8; const float* sa; const float* cm;
    __device__ __forceinline__ void operator()(const i32x4 (&acc)[2][2][4][2], const Unit& u, int wr, int wc, int fr, int fq, const PG8_LAS float* scl) const {
        const int row0 = u.pm * BM + wr * 64 + fr;
        const PG8_LAS float* cp = scl + 256 + wc * 32 + 8 * fq; const PG8_LAS float* sp = scl + wr * 64 + fr;
        f32x4 sb[2][2];
#pragma unroll
        for (int bj = 0; bj < 2; ++bj)
#pragma unroll
            for (int n = 0; n < 2; ++n) sb[bj][n] = *(const PG8_LAS f32x4*)(cp + bj * HALF + 4 * n) * (1.0f / 127.0f);
#define EP_DQ(ai, bj, m, n, s) (__builtin_convertvector(acc[ai][bj][m][n], f32x4) * ((s) * sb[bj][n]))
        if (u.pn < 4) {
            const float* wp = (u.pn < 2 ? qnw : knw) + 8 * fq; const float scl = u.pn < 2 ? 0.125f * 1.4426950408889634f : 1.0f;
            f32x4 wv[2][2];
#pragma unroll
            for (int bj = 0; bj < 2; ++bj)
#pragma unroll
                for (int n = 0; n < 2; ++n) wv[bj][n] = *(const f32x4*)(wp + 32 * bj + 4 * n) * scl;
            const int col0 = u.pn * BM + wc * 64 + 8 * fq;
#pragma unroll
            for (int ai = 0; ai < 2; ++ai)
#pragma unroll
                for (int m = 0; m < 4; ++m) { float ss = 0.f; const float s = sp[ai * HALF + m * 16]; f32x4 vv[2][2];
#pragma unroll
                    for (int bj = 0; bj < 2; ++bj)
#pragma unroll
                        for (int n = 0; n < 2; ++n) { const f32x4 v = EP_DQ(ai, bj, m, n, s); vv[bj][n] = v; ss += (v[0] * v[0] + v[1] * v[1]) + (v[2] * v[2] + v[3] * v[3]); }
                    ss += __shfl_xor(ss, 16); ss += __shfl_xor(ss, 32);
                    const float rstd = __builtin_amdgcn_rsqf(ss * (1.0f / 64.0f) + 1e-6f);
                    bf16_t* rowp = O + (size_t)(row0 + ai * HALF + m * 16) * PROJ_N + col0;
#pragma unroll
                    for (int bj = 0; bj < 2; ++bj) { const f32x4 v0 = vv[bj][0] * rstd * wv[bj][0], v1 = vv[bj][1] * rstd * wv[bj][1];
                        u32x4 w; w.x = pkbf(v0[0], v0[1]); w.y = pkbf(v0[2], v0[3]); w.z = pkbf(v1[0], v1[1]); w.w = pkbf(v1[2], v1[3]);
                        *(u32x4*)(rowp + bj * 32) = w; } }
            return;
        }
        const int col0 = u.pn * BM + wc * 32 + 8 * fq;
        if (u.pn >= 22) {
            const int gc0 = col0 - NGATE0;
#pragma unroll
            for (int bj = 0; bj < 2; ++bj)
#pragma unroll
                for (int n = 0; n < 2; ++n) sb[bj][n] = sb[bj][n] * -1.4426950408889634f;
#pragma unroll
            for (int ai = 0; ai < 2; ++ai)
#pragma unroll
                for (int m = 0; m < 4; ++m) { unsigned char* rowp = G8 + (size_t)(row0 + ai * HALF + m * 16) * NGATE + gc0; const float s = sp[ai * HALF + m * 16];
#pragma unroll
                    for (int bj = 0; bj < 2; ++bj) { const f32x4 v0 = EP_DQ(ai, bj, m, 0, s), v1 = EP_DQ(ai, bj, m, 1, s); unsigned q[8];
#pragma unroll
                        for (int k = 0; k < 4; ++k) { q[k] = (unsigned)(255.0f * __builtin_amdgcn_rcpf(1.f + __builtin_amdgcn_exp2f(v0[k])) + 0.5f);
                                                      q[4 + k] = (unsigned)(255.0f * __builtin_amdgcn_rcpf(1.f + __builtin_amdgcn_exp2f(v1[k])) + 0.5f); }
                        typedef unsigned u32x2v __attribute__((ext_vector_type(2)));
                        *(u32x2v*)(rowp + bj * HALF) = (u32x2v){q[0] | (q[1] << 8) | (q[2] << 16) | (q[3] << 24), q[4] | (q[5] << 8) | (q[6] << 16) | (q[7] << 24)}; } }
            return;
        }
#pragma unroll
        for (int ai = 0; ai < 2; ++ai)
#pragma unroll
            for (int m = 0; m < 4; ++m) { bf16_t* rowp = O + (size_t)(row0 + ai * HALF + m * 16) * PROJ_N + col0; const float s = sp[ai * HALF + m * 16];
#pragma unroll
                for (int bj = 0; bj < 2; ++bj) { const f32x4 v0 = EP_DQ(ai, bj, m, 0, s), v1 = EP_DQ(ai, bj, m, 1, s);
                    u32x4 w; w.x = pkbf(v0[0], v0[1]); w.y = pkbf(v0[2], v0[3]); w.z = pkbf(v1[0], v1[1]); w.w = pkbf(v1[2], v1[3]);
                    *(u32x4*)(rowp + bj * HALF) = w; } }
#undef EP_DQ
    }
};
struct EpiResid {
    static constexpr bool PERM = true, AFTER_DRAIN = false, I8 = false; typedef f32x4 acc_t; __device__ __forceinline__ bool keep_acc(const Unit&) const { return false; } const float* x32; bf16_t* xb; const float* gate;
    __device__ __forceinline__ void operator()(const f32x4 (&acc)[2][2][4][2], const Unit& u, int wr, int wc, int fr, int fq) const {
        const int col0 = u.pn * BM + wc * 32 + 8 * fq; const float* gp = gate + ((u.pm * BM) >> 14) * 6144 + col0;
        f32x4 gv[2][2];
#pragma unroll
        for (int bj = 0; bj < 2; ++bj)
#pragma unroll
            for (int n = 0; n < 2; ++n) gv[bj][n] = *(const f32x4*)(gp + bj * HALF + 4 * n);
        const size_t off0 = (size_t)(u.pm * BM + wr * 64 + fr) * 1024 + col0;
        if (x32 != nullptr) {
#pragma unroll
            for (int ai = 0; ai < 2; ++ai)
#pragma unroll
                for (int mp = 0; mp < 2; ++mp) { f32x4 xi[2][2][2];
#pragma unroll
                    for (int m2 = 0; m2 < 2; ++m2)
#pragma unroll
                        for (int bj = 0; bj < 2; ++bj) { const float* xp = x32 + off0 + (size_t)(ai * HALF + (2 * mp + m2) * 16) * 1024 + bj * HALF; xi[m2][bj][0] = *(const f32x4*)xp; xi[m2][bj][1] = *(const f32x4*)(xp + 4); }
#pragma unroll
                    for (int m2 = 0; m2 < 2; ++m2)
#pragma unroll
                        for (int bj = 0; bj < 2; ++bj) { const int m = 2 * mp + m2; const f32x4 v0 = xi[m2][bj][0] + gv[bj][0] * acc[ai][bj][m][0], v1 = xi[m2][bj][1] + gv[bj][1] * acc[ai][bj][m][1];
                            u32x4 w; w.x = pkbf(v0[0], v0[1]); w.y = pkbf(v0[2], v0[3]); w.z = pkbf(v1[0], v1[1]); w.w = pkbf(v1[2], v1[3]);
                            *(u32x4*)(xb + off0 + (size_t)(ai * HALF + m * 16) * 1024 + bj * HALF) = w; } }
        } else {
#pragma unroll
            for (int ai = 0; ai < 2; ++ai) { u32x4 xr[4][2];
#pragma unroll
                for (int m = 0; m < 4; ++m)
#pragma unroll
                    for (int bj = 0; bj < 2; ++bj) xr[m][bj] = *(const u32x4*)(xb + off0 + (size_t)(ai * HALF + m * 16) * 1024 + bj * HALF);
#pragma unroll
                for (int m = 0; m < 4; ++m)
#pragma unroll
                    for (int bj = 0; bj < 2; ++bj) { const u32x4 r = xr[m][bj]; const f32x4 a0 = acc[ai][bj][m][0], a1 = acc[ai][bj][m][1], g0 = gv[bj][0], g1 = gv[bj][1];
                        u32x4 w; w.x = pkbf(__builtin_bit_cast(float, r.x << 16) + g0[0] * a0[0], __builtin_bit_cast(float, r.x & 0xffff0000u) + g0[1] * a0[1]);
                        w.y = pkbf(__builtin_bit_cast(float, r.y << 16) + g0[2] * a0[2], __builtin_bit_cast(float, r.y & 0xffff0000u) + g0[3] * a0[3]);
                        w.z = pkbf(__builtin_bit_cast(float, r.z << 16) + g1[0] * a1[0], __builtin_bit_cast(float, r.z & 0xffff0000u) + g1[1] * a1[1]);
                        w.w = pkbf(__builtin_bit_cast(float, r.w << 16) + g1[2] * a1[2], __builtin_bit_cast(float, r.w & 0xffff0000u) + g1[3] * a1[3]);
                        *(u32x4*)(xb + off0 + (size_t)(ai * HALF + m * 16) * 1024 + bj * HALF) = w; } }
        }
    }
};
struct EpiSwiglu {
    static constexpr bool PERM = true, AFTER_DRAIN = false, I8 = true; typedef i32x4 acc_t; __device__ __forceinline__ bool keep_acc(const Unit&) const { return false; } bf16_t* U; const float* sa; const float* cm;
    __device__ __forceinline__ void operator()(const i32x4 (&acc)[2][2][4][2], const Unit& u, int wr, int wc, int fr, int fq, const PG8_LAS float* scl) const {
        const int row0 = u.pm * BM + wr * 64 + fr, col0 = (u.pn % 22) * HALF + wc * 32 + 8 * fq;
        const PG8_LAS float* cp = scl + 256 + wc * 32 + 8 * fq; const PG8_LAS float* sp = scl + wr * 64 + fr;
        f32x4 sb[2][2];
#pragma unroll
        for (int bj = 0; bj < 2; ++bj)
#pragma unroll
            for (int n = 0; n < 2; ++n) sb[bj][n] = *(const PG8_LAS f32x4*)(cp + bj * HALF + 4 * n);
#pragma unroll
        for (int ai = 0; ai < 2; ++ai) { float sr[4];
#pragma unroll
            for (int m = 0; m < 4; ++m) sr[m] = sp[ai * HALF + m * 16] * (1.0f / 127.0f);
#pragma unroll
            for (int m = 0; m < 4; ++m) { float o[8]; const float s = sr[m];
#pragma unroll
                for (int n = 0; n < 2; ++n)
#pragma unroll
                    for (int k = 0; k < 4; ++k) { const float a = (float)acc[ai][0][m][n][k] * (s * sb[0][n][k]), g = (float)acc[ai][1][m][n][k] * (s * sb[1][n][k]);
                        o[4 * n + k] = a * __builtin_amdgcn_rcpf(1.f + __builtin_amdgcn_exp2f(-1.4426950408889634f * a)) * g; }
                u32x4 w; w.x = pkbf(o[0], o[1]); w.y = pkbf(o[2], o[3]); w.z = pkbf(o[4], o[5]); w.w = pkbf(o[6], o[7]);
                *(u32x4*)(U + (size_t)(row0 + ai * HALF + m * 16) * DFF + col0) = w; } }
    }
};
struct EpiSwigluBf {
    static constexpr bool PERM = true, AFTER_DRAIN = false, I8 = false; typedef f32x4 acc_t; __device__ __forceinline__ bool keep_acc(const Unit&) const { return false; } bf16_t* U;
    __device__ __forceinline__ void operator()(const f32x4 (&acc)[2][2][4][2], const Unit& u, int wr, int wc, int fr, int fq) const {
        const int row0 = u.pm * BM + wr * 64 + fr, col0 = (u.pn % 22) * HALF + wc * 32 + 8 * fq;
#pragma unroll
        for (int ai = 0; ai < 2; ++ai)
#pragma unroll
            for (int m = 0; m < 4; ++m) { float o[8];
#pragma unroll
                for (int n = 0; n < 2; ++n)
#pragma unroll
                    for (int k = 0; k < 4; ++k) { const float a = acc[ai][0][m][n][k], g = acc[ai][1][m][n][k]; o[4 * n + k] = a * __builtin_amdgcn_rcpf(1.f + __builtin_amdgcn_exp2f(-1.4426950408889634f * a)) * g; }
                u32x4 w; w.x = pkbf(o[0], o[1]); w.y = pkbf(o[2], o[3]); w.z = pkbf(o[4], o[5]); w.w = pkbf(o[6], o[7]);
                *(u32x4*)(U + (size_t)(row0 + ai * HALF + m * 16) * DFF + col0) = w; }
    }
};
struct EpiMoeOut {
    static constexpr bool PERM = true, AFTER_DRAIN = false, I8 = false; typedef f32x4 acc_t; __device__ __forceinline__ bool keep_acc(const Unit&) const { return false; } bf16_t* O; const float* wpos;
    __device__ __forceinline__ void operator()(const f32x4 (&acc)[2][2][4][2], const Unit& u, int wr, int wc, int fr, int fq) const {
        const int row0 = u.pm * BM + wr * 64 + fr, col0 = (u.pn & 3) * BM + wc * 32 + 8 * fq;
#pragma unroll
        for (int ai = 0; ai < 2; ++ai)
#pragma unroll
            for (int m = 0; m < 4; ++m) { const int r = row0 + ai * HALF + m * 16; const float s = wpos[r];
#pragma unroll
                for (int bj = 0; bj < 2; ++bj) { const f32x4 v0 = acc[ai][bj][m][0] * s, v1 = acc[ai][bj][m][1] * s;
                    u32x4 w; w.x = pkbf(v0[0], v0[1]); w.y = pkbf(v0[2], v0[3]); w.z = pkbf(v1[0], v1[1]); w.w = pkbf(v1[2], v1[3]);
                    *(u32x4*)(O + (size_t)r * 1024 + col0 + bj * HALF) = w; } }
    }
};
struct MoeOrder {
    StaticOrder S; int nN; int ts[NEXP];
    __device__ __forceinline__ bool next(int i, Unit& u) const {
        if (!S.next(i, u)) return false;
        int e = 0;
#pragma unroll
        for (int k = 1; k < NEXP; ++k) e += (u.pm >= ts[k]) ? 1 : 0;
        u.pn += e * nN; return true;
    }
    __device__ __forceinline__ void a_ready(const Unit&) const {}
    __device__ __forceinline__ void done(const Unit&) const {}
};
struct EpiMergeChain {
    static constexpr bool PERM = true, AFTER_DRAIN = false, I8 = false; typedef f32x4 acc_t; const unsigned char* G8; bf16_t* O;
    __device__ __forceinline__ bool keep_acc(const Unit& u) const { return (u.pm >> 7) < 2; }
    __device__ __forceinline__ void operator()(f32x4 (&acc)[2][2][4][2], const Unit& u, int wr, int wc, int fr, int fq) const {
        typedef unsigned u32x2v __attribute__((ext_vector_type(2)));
        const int part = u.pm >> 7, pm = u.pm & 127, pn = u.pn & 3;
        const int row0 = pm * BM + wr * 64 + fr, col0 = pn * BM + wc * 32 + 8 * fq;
        const float gmin = 255.0f * 8.6736174e-19f;
        u32x2v ga[2][2][2], gb[2][2][2];
        const GAS unsigned char* gbase = (const GAS unsigned char*)G8 + (size_t)row0 * NGATE + part * 1024 + col0;
#define MC_LOAD(b_, buf_) do { _Pragma("unroll") for (int m2 = 0; m2 < 2; ++m2) _Pragma("unroll") for (int bj = 0; bj < 2; ++bj) { \
            const GAS unsigned char* gp = gbase + (size_t)((((b_) >> 1) * HALF) + (2 * ((b_) & 1) + m2) * 16) * NGATE + bj * HALF; ga[buf_][m2][bj] = *(const GAS u32x2v*)gp; \
            gb[buf_][m2][bj] = part < 2 ? *(const GAS u32x2v*)(gp + 1024) : (u32x2v){0xffffffffu, 0xffffffffu}; } } while (0)
        MC_LOAD(0, 0);
#pragma unroll
        for (int b4 = 0; b4 < 4; ++b4) { const int ai = b4 >> 1, mp = b4 & 1;
            if (b4 < 3) MC_LOAD(b4 + 1, (b4 + 1) & 1);
#pragma unroll
            for (int m2 = 0; m2 < 2; ++m2) { const int m = 2 * mp + m2; const size_t r = (size_t)(row0 + ai * HALF + m * 16);
#pragma unroll
                for (int bj = 0; bj < 2; ++bj) { const u32x2v a = ga[b4 & 1][m2][bj], b = gb[b4 & 1][m2][bj]; float s[8];
#pragma unroll
                    for (int k = 0; k < 8; ++k) { const float ga_ = __builtin_fmaxf((float)((a[k >> 2] >> (8 * (k & 3))) & 0xffu), gmin), gb_ = __builtin_fmaxf((float)((b[k >> 2] >> (8 * (k & 3))) & 0xffu), gmin);
                        s[k] = ga_ * __builtin_amdgcn_rcpf(gb_); }
                    f32x4 v0 = acc[ai][bj][m][0], v1 = acc[ai][bj][m][1];
                    v0[0] *= s[0]; v0[1] *= s[1]; v0[2] *= s[2]; v0[3] *= s[3]; v1[0] *= s[4]; v1[1] *= s[5]; v1[2] *= s[6]; v1[3] *= s[7];
                    acc[ai][bj][m][0] = v0; acc[ai][bj][m][1] = v1;
                    if (part == 2) { u32x4 w; w.x = pkbf(v0[0], v0[1]); w.y = pkbf(v0[2], v0[3]); w.z = pkbf(v1[0], v1[1]); w.w = pkbf(v1[2], v1[3]);
                        *(u32x4*)(O + r * 1024 + col0 + bj * HALF) = w; } } }
        }
#undef MC_LOAD
    }
};
struct MergeOrder {
    StaticOrder S;
    __device__ __forceinline__ bool next(int i, Unit& u) const {
        const int j = i / 3, part = i - 3 * j;
        if (!S.next(j, u)) return false;
        u.pm += part * 128; u.pn += part * 4; return true;
    }
    __device__ __forceinline__ void a_ready(const Unit&) const {}
    __device__ __forceinline__ void done(const Unit&) const {}
};
}

struct WG { LAS unsigned char* lds; int tid, lane, wave, G, bid; };

struct CvtItem { const float* src; unsigned char* dst; int pitch, K; const float* cm; };
__device__ __forceinline__ void cvt_load(const CvtItem& it, f32x4 (&r)[8], int lane) {
#pragma unroll
    for (int i = 0; i < 8; ++i) r[i] = *(const f32x4*)(it.src + (size_t)(8 * i + (lane >> 3)) * it.pitch + (lane & 7) * 4);
}
__device__ __forceinline__ void cvt_finish(const CvtItem& it, const f32x4 (&r)[8], LAS float* scr, int lane) {
#pragma unroll
    for (int i = 0; i < 8; ++i) *(LAS f32x4*)(scr + (8 * i + (lane >> 3)) * 36 + (((lane & 7) * 4 + 4 * i) & 31)) = r[i];
    LDS_WAIT(); asm volatile("" ::: "memory");
    const int c = lane & 7;
    if (it.cm != nullptr) {
#pragma unroll
        for (int j = 0; j < 4; ++j) { const int n = (lane >> 3) + 8 * j; const LAS float* s = scr + (8 * c) * 36 + ((n + 4 * c) & 31);
            const float inv = 127.0f * frcp(__builtin_fmaxf(it.cm[n], 1e-30f)); unsigned q[8];
#pragma unroll
            for (int i = 0; i < 8; ++i) q[i] = (unsigned)(int)__builtin_rintf(s[i * 36] * inv) & 0xffu;
#if I8_DENSE == 2
            { const float dq = it.cm[n] * (1.0f / 127.0f); float f[8];
#pragma unroll
              for (int i = 0; i < 8; ++i) f[i] = (float)(int)(signed char)q[i] * dq;
              v4u o4; o4.x = pk2(f[0], f[1]); o4.y = pk2(f[2], f[3]); o4.z = pk2(f[4], f[5]); o4.w = pk2(f[6], f[7]);
              *(GAS v4u*)(it.dst + ((size_t)n * it.K + 8 * c) * 2) = o4; }
#else
            v2u o; o.x = q[0] | (q[1] << 8) | (q[2] << 16) | (q[3] << 24); o.y = q[4] | (q[5] << 8) | (q[6] << 16) | (q[7] << 24);
            *(GAS v2u*)(it.dst + (size_t)n * it.K + 8 * c) = o;
#endif
            }
    } else {
#pragma unroll
    for (int j = 0; j < 4; ++j) { const int n = (lane >> 3) + 8 * j; const LAS float* s = scr + (8 * c) * 36 + ((n + 4 * c) & 31);
        v4u o; o.x = pk2(s[0 * 36], s[1 * 36]); o.y = pk2(s[2 * 36], s[3 * 36]); o.z = pk2(s[4 * 36], s[5 * 36]); o.w = pk2(s[6 * 36], s[7 * 36]);
        *(GAS v4u*)(it.dst + ((size_t)n * it.K + 8 * c) * 2) = o; }
    }
    LDS_WAIT(); asm volatile("" ::: "memory");
}
__device__ __forceinline__ int cvt_drow(int mode, int row_off, int n0) { return mode == 0 ? row_off + n0 : mode == 3 ? ((n0 & ~255) + 128 * ((n0 >> 5) & 1) + 32 * ((n0 >> 6) & 3)) : ((n0 >> 7) * 256 + (n0 & 127) + (mode == 2 ? 128 : 0)); }
__device__ __forceinline__ CvtItem cvt_mk(const float* W, int pitch, int col0, int K, int nblk, void* WT, int mode, int row_off, int idx, const float* cm = nullptr) {
    const int kb = idx / nblk, nb = idx - kb * nblk, n0 = nb * 32;
    const int drow = cvt_drow(mode, row_off, n0);
    CvtItem it; it.src = W + (size_t)(kb * 64) * pitch + col0 + n0; it.dst = (unsigned char*)WT + ((size_t)drow * K + kb * 64) * ((cm != nullptr && I8_DENSE != 2) ? 1 : 2); it.pitch = pitch; it.K = K; it.cm = cm != nullptr ? cm + drow : nullptr; return it;
}
constexpr int CVT_WIN = 512 + 2304 + 1536, CVT_L = 768 + 512, CVT_F = 3 * 1408, CVT_PRO = DEPTH * CVT_L + 2 * 1408, CVT_QWIN = DEPTH * CVT_WIN, CVT_Q13D = 2 * 2816, CVT_MOE = NEXP * CVT_F;
__device__ __forceinline__ CvtItem cvt_ffn(const float* w1, const float* w3, const float* w2, void* w13, bf16* w2t, const float* cm, int r) {
    if (r < 1408) return cvt_mk(w1, DFF, 0, 1024, 88, w13, 1, 0, r, cm);
    if (r < 2816) return cvt_mk(w3, DFF, 0, 1024, 88, w13, 2, 0, r - 1408, cm);
    return cvt_mk(w2, 1024, 0, DFF, 32, w2t, 0, 0, r - 2816);
}
__device__ __forceinline__ CvtItem cvt_pro_item(const Ctx& C, int it) {
    if (it < DEPTH * CVT_L) { const int l = it / CVT_L; int r = it - l * CVT_L;
        if (r < 768) { const int i = r >> 8; return cvt_mk(C.w_branch + (size_t)(l * 3 + i) * 512 * 1024, 1024, 0, 512, 32, (bf16*)(C.ws + WS_WBR) + (size_t)(l * 3 + i) * 1024 * 512, 0, 0, r & 255); }
        r -= 768; return cvt_mk(C.w_out + (size_t)l * 1024 * 1024, 1024, 0, 1024, 32, (bf16*)(C.ws + WS_WOUT) + (size_t)l * 1024 * 1024, 0, 0, r);
    }
    it -= DEPTH * CVT_L; const int i = it / 1408;
    return cvt_mk(C.ffn_w2 + (size_t)i * DFF * 1024, 1024, 0, DFF, 32, (bf16*)(C.ws + WS_W2D) + (size_t)i * 1024 * DFF, 0, 0, it - i * 1408);
}
__device__ __forceinline__ CvtItem cvt_qwin_item(const Ctx& C, int it) {
    const int l = it / CVT_WIN; int r = it - l * CVT_WIN;
    const float* wi = C.w_in + (size_t)l * 1024 * D_IN; unsigned char* win = C.ws + WS_WIN + (size_t)l * WIN_ROWS * 1024; const float* cm = (const float*)C.ws + CM_WIN + l * WIN_ROWS;
    if (r < 512) return cvt_mk(wi, D_IN, 0, 1024, 32, win, 3, 0, r, cm);
    r -= 512; if (r < 2304) return cvt_mk(wi, D_IN, 1024, 1024, 144, win, 0, 1024, r, cm);
    r -= 2304; return cvt_mk(wi, D_IN, 5640, 1024, 96, win, 0, NGATE0, r, cm);
}
__device__ __forceinline__ CvtItem cvt_q13d_item(const Ctx& C, int it) {
    const int i = it / 2816, r = it - i * 2816, which = r >= 1408 ? 1 : 0;
    const float* const p1 = C.ffn_w1; const float* const p3 = C.ffn_w3; const float* W = (which ? p3 : p1) + (size_t)i * 1024 * DFF;
    return cvt_mk(W, DFF, 0, 1024, 88, C.ws + WS_W13D + (size_t)i * 5632 * 1024 * (I8_DENSE == 1 ? 1 : 2), 1 + which, 0, r - which * 1408, I8_DENSE ? (const float*)C.ws + CM_W13D + i * 5632 : nullptr);
}
__device__ __forceinline__ CvtItem cvt_moe_item(const Ctx& C, int mi, int it) {
    const int e = it / CVT_F; const size_t ge = (size_t)(mi * NEXP + e);
    return cvt_ffn(C.moe_w1 + ge * 1024 * DFF, C.moe_w3 + ge * 1024 * DFF, C.moe_w2 + ge * DFF * 1024, C.ws + WS_W13M + (size_t)e * 5632 * 1024 * (I8_MOE ? 1 : 2), (bf16*)(C.ws + WS_W2M) + (size_t)e * 1024 * DFF,
                   I8_MOE ? (const float*)C.ws + CM_W13M + (mi * NEXP + e) * 5632 : nullptr, it - e * CVT_F);
}
constexpr int AMX_PER = 88 * 8, AMX_FFN = 36 * AMX_PER, AMX_WIN_PER = 272 * 8, AMX_ITEMS = AMX_FFN + DEPTH * AMX_WIN_PER;
__device__ __forceinline__ void amx_run(const Ctx& C, const WG& w, int sel) {
    const int gw = w.bid * NWAVES + w.wave, NGW = w.G * NWAVES, lane = w.lane;
    const int nitems = sel == 0 ? 4 * AMX_PER + DEPTH * AMX_WIN_PER : 16 * AMX_PER, base = sel == 0 ? 0 : (4 + 16 * (sel - 1)) * AMX_PER;
    const float* const pd1 = C.ffn_w1; const float* const pd3 = C.ffn_w3; const float* const pm1 = C.moe_w1; const float* const pm3 = C.moe_w3; const float* const pwi = C.w_in;
    for (int j = gw; j < nitems; j += NGW) {
        const int it = (sel == 0 && j >= 4 * AMX_PER) ? AMX_FFN + (j - 4 * AMX_PER) : base + j;
        const float* src; unsigned* cm; int pitch;
        if (it < AMX_FFN) {
            const int mat = it / AMX_PER, r = it - mat * AMX_PER, kp = r / 88, nb = r - kp * 88, set = mat >> 1, which = mat & 1, n0 = nb * 32;
            const float* W = set < 2 ? (which ? pd3 : pd1) + (size_t)set * 1024 * DFF : (which ? pm3 : pm1) + (size_t)(set - 2) * 1024 * DFF;
            src = W + (size_t)(kp * 128) * DFF + n0; pitch = DFF; cm = (unsigned*)C.ws + CM_W13D + set * 5632 + cvt_drow(which ? 2 : 1, 0, n0);
        } else {
            const int r0 = it - AMX_FFN, l = r0 / AMX_WIN_PER, r = r0 - l * AMX_WIN_PER, kp = r / 272, b = r - kp * 272;
            const int col = b < 176 ? 32 * b : 5640 + 32 * (b - 176), drow = b < 32 ? cvt_drow(3, 0, 32 * b) : b < 176 ? 32 * b : NGATE0 + 32 * (b - 176);
            src = pwi + (size_t)l * 1024 * D_IN + (size_t)(kp * 128) * D_IN + col; pitch = D_IN; cm = (unsigned*)C.ws + CM_WIN + l * WIN_ROWS + drow;
        }
        src += (size_t)(lane >> 3) * pitch + (lane & 7) * 4;
        f32x4 rr[16];
#pragma unroll
        for (int i = 0; i < 16; ++i) rr[i] = *(const f32x4*)(src + (size_t)(8 * i) * pitch);
        float m0 = 0.f, m1 = 0.f, m2 = 0.f, m3 = 0.f;
#pragma unroll
        for (int i = 0; i < 16; ++i) { const f32x4 t = rr[i]; m0 = __builtin_fmaxf(m0, __builtin_fabsf(t.x)); m1 = __builtin_fmaxf(m1, __builtin_fabsf(t.y)); m2 = __builtin_fmaxf(m2, __builtin_fabsf(t.z)); m3 = __builtin_fmaxf(m3, __builtin_fabsf(t.w)); }
#define AMX_RED_(v) v = __builtin_fmaxf(v, __shfl_xor(v, 8)); v = __builtin_fmaxf(v, __shfl_xor(v, 16)); v = __builtin_fmaxf(v, __shfl_xor(v, 32));
        AMX_RED_(m0) AMX_RED_(m1) AMX_RED_(m2) AMX_RED_(m3)
#undef AMX_RED_
        if (lane < 8) { cm += lane * 4;
            __hip_atomic_fetch_max(cm + 0, __builtin_bit_cast(unsigned, m0), RLX_AGENT); __hip_atomic_fetch_max(cm + 1, __builtin_bit_cast(unsigned, m1), RLX_AGENT);
            __hip_atomic_fetch_max(cm + 2, __builtin_bit_cast(unsigned, m2), RLX_AGENT); __hip_atomic_fetch_max(cm + 3, __builtin_bit_cast(unsigned, m3), RLX_AGENT); }
    }
}
#define CVT_RUN(NITEMS, MKITEM) do { LAS float* scr_ = (LAS float*)(w.lds + w.wave * 9216); const int gw_ = w.bid * NWAVES + w.wave, NGW_ = w.G * NWAVES; \
        int it_ = gw_; if (it_ < (NITEMS)) { CvtItem cur_ = MKITEM(it_); f32x4 ra_[8], rb_[8]; cvt_load(cur_, ra_, w.lane); \
            for (;;) { const int n1_ = it_ + NGW_; CvtItem nx_ = cur_; if (n1_ < (NITEMS)) { nx_ = MKITEM(n1_); cvt_load(nx_, rb_, w.lane); } cvt_finish(cur_, ra_, scr_, w.lane); if (n1_ >= (NITEMS)) break; \
                       const int n2_ = n1_ + NGW_; cur_ = nx_; if (n2_ < (NITEMS)) { cur_ = MKITEM(n2_); cvt_load(cur_, ra_, w.lane); } cvt_finish(nx_, rb_, scr_, w.lane); if (n2_ >= (NITEMS)) break; it_ = n2_; } } } while (0)

__device__ __forceinline__ void phase_prologue(const Ctx& C, const WG& w) {
    float* MOD = (float*)(C.ws + WS_MOD);
    {
        LAS float* cond = (LAS float*)(w.lds + 73728); LAS float* red = cond + 2048;
        for (int i = w.tid; i < 2048; i += NTHR) { const float c = C.c[i]; cond[i] = c * fsigmoid(c); }
        __syncthreads();
        for (int u = w.bid; u < 192; u += w.G) {
            const int l = u / 48, nb = u % 48, c4 = w.tid & 31, kq = w.tid >> 5;
            const float* W = C.w_mod + (size_t)l * 1024 * 6144 + nb * 128 + c4 * 4;
            f32x4 a0 = {0.f, 0.f, 0.f, 0.f}, a1 = {0.f, 0.f, 0.f, 0.f};
#pragma unroll 16
            for (int k = kq * 64; k < kq * 64 + 64; ++k) { const f32x4 wv = *(const f32x4*)(W + (size_t)k * 6144); a0 += cond[k] * wv; a1 += cond[1024 + k] * wv; }
            *(LAS f32x4*)(red + (kq * 2 + 0) * 128 + c4 * 4) = a0; *(LAS f32x4*)(red + (kq * 2 + 1) * 128 + c4 * 4) = a1;
            __syncthreads();
            if (w.tid < 256) { const int b = w.tid >> 7, cc = w.tid & 127; float s = 0.f;
#pragma unroll
                for (int q = 0; q < 16; ++q) s += red[(q * 2 + b) * 128 + cc];
                MOD[(l * 2 + b) * 6144 + nb * 128 + cc] = s + C.b_mod[l * 6144 + nb * 128 + cc]; }
            __syncthreads();
        }
    }
#define MKI_(x) cvt_pro_item(C, (x))
    CVT_RUN(CVT_PRO, MKI_);
#undef MKI_
    amx_run(C, w, 0);
}
__device__ __forceinline__ void phase_cvt_qwin(const Ctx& C, const WG& w) {
#define MKI_(x) cvt_qwin_item(C, (x))
    CVT_RUN(CVT_QWIN, MKI_);
#undef MKI_
}
__device__ __forceinline__ void phase_cvt_q13d(const Ctx& C, const WG& w) {
#define MKI_(x) cvt_q13d_item(C, (x))
    CVT_RUN(CVT_Q13D, MKI_);
#undef MKI_
}
__device__ __forceinline__ void phase_cvt_moe(const Ctx& C, const WG& w, int mi) {
#define MKI_(x) cvt_moe_item(C, mi, (x))
    CVT_RUN(CVT_MOE, MKI_);
#undef MKI_
}

template <int MODE>
__device__ __forceinline__ void phase_norm(const Ctx& C, const WG& w, int l, bool combine) {
    const float* MOD = (const float*)(C.ws + WS_MOD);
    const bool x32 = (MODE == 0 && l == 0);
    const float* xin = C.x; bf16* XB = (bf16*)(C.ws + WS_XB);
    bf16* H = (bf16*)(C.ws + WS_H);
    LAS float* wa = (LAS float*)w.lds;
    if (MODE == 0) { const float* src = C.w_in + (size_t)l * 1024 * D_IN + 5632;
        for (int i = w.tid; i < 8192; i += NTHR) { const int k = i >> 3, c = i & 7, slot = (((k >> 8) * 4 + (k & 3)) * 64 + ((k >> 2) & 63)); wa[((c >> 2) * 1024 + slot) * 4 + (c & 3)] = src[(size_t)k * D_IN + c]; } }
    if (MODE == 2) { const float* src = C.router_w + (size_t)(l >> 1) * 8192;
        for (int i = w.tid; i < 8192; i += NTHR) { const int k = i >> 3, c = i & 7, slot = (((k >> 8) * 4 + (k & 3)) * 64 + ((k >> 2) & 63)); wa[((c >> 2) * 1024 + slot) * 4 + (c & 3)] = src[i]; } }
    __syncthreads();
    const float* nw = (MODE == 0 ? C.norm1_w : C.norm2_w) + l * 1024;
    const int sh_off = MODE == 0 ? 0 : 3072, sc_off = sh_off + 1024;
    const int gw = w.bid * NWAVES + w.wave, NGW = w.G * NWAVES, lane = w.lane;
    f32x4 av[4], sv[4]; int curb = -1;
    const bf16* OP = (const bf16*)(C.ws + WS_AS); const unsigned* POS = (const unsigned*)(C.ws + WS_POS);
    f32x4 vn[4]; v2u rn[4], rn2[4];
#pragma unroll
    for (int j = 0; j < 4; ++j) { if (x32) vn[j] = *(const f32x4*)(xin + (size_t)gw * 1024 + 4 * lane + 256 * j); else { rn[j] = *(const v2u*)(XB + (size_t)gw * 1024 + 4 * lane + 256 * j); rn2[j] = *(const v2u*)(XB + (size_t)(gw + NGW) * 1024 + 4 * lane + 256 * j); } }
    for (int m0 = gw; m0 < MTOK; m0 += 2 * NGW) {
#pragma unroll
      for (int u = 0; u < 2; ++u) { const int m = m0 + u * NGW;
        const int b = m >> 14;
        if (b != curb) { curb = b; const float* mp = MOD + (l * 2 + b) * 6144;
#pragma unroll
            for (int j = 0; j < 4; ++j) { const f32x4 nv = *(const f32x4*)(nw + 4 * lane + 256 * j), sc = *(const f32x4*)(mp + sc_off + 4 * lane + 256 * j); av[j] = nv * (sc + 1.0f); sv[j] = *(const f32x4*)(mp + sh_off + 4 * lane + 256 * j); } }
        f32x4 v[4];
#pragma unroll
        for (int j = 0; j < 4; ++j) { const v2u r = u == 0 ? rn[j] : rn2[j]; const f32x4 dec = {bflo(r.x), bfhi(r.x), bflo(r.y), bfhi(r.y)}; v[j] = x32 ? vn[j] : dec; }
        if (x32) { if (m + NGW < MTOK) {
#pragma unroll
            for (int j = 0; j < 4; ++j) vn[j] = *(const f32x4*)(xin + (size_t)(m + NGW) * 1024 + 4 * lane + 256 * j); } }
        else if (m + 2 * NGW < MTOK) {
#pragma unroll
            for (int j = 0; j < 4; ++j) { const v2u r = *(const v2u*)(XB + (size_t)(m + 2 * NGW) * 1024 + 4 * lane + 256 * j); if (u == 0) rn[j] = r; else rn2[j] = r; } }
        if (combine) {
            const unsigned p0 = POS[2 * m], p1 = POS[2 * m + 1]; const float* g2 = MOD + ((l - 1) * 2 + b) * 6144 + 5120;
#pragma unroll
            for (int j = 0; j < 4; ++j) { const v2u a = *(const v2u*)(OP + (size_t)p0 * 1024 + 4 * lane + 256 * j), bq = *(const v2u*)(OP + (size_t)p1 * 1024 + 4 * lane + 256 * j);
                const f32x4 gg = *(const f32x4*)(g2 + 4 * lane + 256 * j);
                f32x4 s; s.x = bflo(a.x) + bflo(bq.x); s.y = bfhi(a.x) + bfhi(bq.x); s.z = bflo(a.y) + bflo(bq.y); s.w = bfhi(a.y) + bfhi(bq.y);
                v[j] = v[j] + gg * s; v2u xo; xo.x = pk2(v[j].x, v[j].y); xo.y = pk2(v[j].z, v[j].w); *(v2u*)(XB + (size_t)m * 1024 + 4 * lane + 256 * j) = xo; }
        }
        float ss = 0.f;
#pragma unroll
        for (int j = 0; j < 4; ++j) ss += (v[j].x * v[j].x + v[j].y * v[j].y) + (v[j].z * v[j].z + v[j].w * v[j].w);
        const float rstd = 1.0f / sqrtf(wave_sum(ss) * (1.0f / 1024.0f) + NORM_EPS);
        if ((MODE == 1 && !I8_DENSE) || (MODE == 2 && !I8_MOE)) {
#pragma unroll
        for (int j = 0; j < 4; ++j) { v[j] = v[j] * rstd * av[j] + sv[j];
            v2u o; o.x = pk2(v[j].x, v[j].y); o.y = pk2(v[j].z, v[j].w); *(v2u*)(H + (size_t)m * 1024 + 4 * lane + 256 * j) = o; }
        } else {
            float am = 0.f;
#pragma unroll
            for (int j = 0; j < 4; ++j) { v[j] = v[j] * rstd * av[j] + sv[j];
                am = __builtin_fmaxf(am, __builtin_fmaxf(__builtin_fmaxf(__builtin_fabsf(v[j].x), __builtin_fabsf(v[j].y)), __builtin_fmaxf(__builtin_fabsf(v[j].z), __builtin_fabsf(v[j].w)))); }
            am = wave_max_nonneg(am);
            const float inv = 127.0f / __builtin_fmaxf(am, 1e-30f);
#pragma unroll
            for (int j = 0; j < 4; ++j) { const unsigned q0 = (unsigned)(int)__builtin_rintf(v[j].x * inv) & 0xffu, q1 = (unsigned)(int)__builtin_rintf(v[j].y * inv) & 0xffu, q2 = (unsigned)(int)__builtin_rintf(v[j].z * inv) & 0xffu, q3 = (unsigned)(int)__builtin_rintf(v[j].w * inv);
#if I8_DENSE == 2
                { const float dq = am * (1.0f / 127.0f); v2u o; o.x = pk2((float)(int)(signed char)q0 * dq, (float)(int)(signed char)q1 * dq); o.y = pk2((float)(int)(signed char)q2 * dq, (float)(int)(signed char)(q3 & 0xffu) * dq);
                  *(v2u*)(H + (size_t)m * 1024 + 4 * lane + 256 * j) = o; }
#else
                *(unsigned*)((unsigned char*)H + (size_t)m * 1024 + 4 * lane + 256 * j) = q0 | (q1 << 8) | (q2 << 16) | (q3 << 24);
#endif
                }
            if (lane == 0) ((float*)(C.ws + WS_SA))[m] = am * (1.0f / 127.0f);
        }
        if (MODE != 1) {
            f32x4 aq0 = {0.f, 0.f, 0.f, 0.f}, aq1 = {0.f, 0.f, 0.f, 0.f};
#pragma unroll
            for (int j = 0; j < 4; ++j)
#pragma unroll
                for (int i = 0; i < 4; ++i) { const LAS f32x4* wp = (const LAS f32x4*)(wa + ((j * 4 + i) * 64 + lane) * 4); const f32x4 w0 = wp[0], w1 = wp[1024]; const float hv = v[j][i];
                    aq0 = aq0 + hv * w0; aq1 = aq1 + hv * w1; }
            float a[8] = {aq0.x, aq0.y, aq0.z, aq0.w, aq1.x, aq1.y, aq1.z, aq1.w};
#pragma unroll
            for (int c = 0; c < 8; ++c) a[c] = wave_sum(a[c]);
            if (MODE == 0) { if (lane == 0) { float* cp = (float*)(C.ws + WS_CIF) + (size_t)m * 8; *(f32x4*)cp = (f32x4){a[0], a[1], a[2], a[3]}; *(f32x4*)(cp + 4) = (f32x4){a[4], a[5], a[6], a[7]}; } }
            if (MODE == 2 && lane == 0) {
                const float* rb = C.router_b + (l >> 1) * 8;
                float b1 = -INFINITY, b2 = -INFINITY; int e1 = 0, e2 = 0;
#pragma unroll
                for (int c = 0; c < 8; ++c) { const float lg = a[c] + rb[c]; if (lg > b1) { b2 = b1; e2 = e1; b1 = lg; e1 = c; } else if (lg > b2) { b2 = lg; e2 = c; } }
                const float w1 = 1.0f / (1.0f + expf(b2 - b1));
                ((unsigned*)(C.ws + WS_RE))[m] = (unsigned)e1 | ((unsigned)e2 << 8);
                *(f32x2*)((float*)(C.ws + WS_RW) + 2 * (size_t)m) = (f32x2){w1, 1.0f - w1};
                unsigned* cnt = (unsigned*)C.ws + CW_CNT + (l >> 1) * 2048 + (m >> 7) * 8;
                __hip_atomic_fetch_add(cnt + e1, 1u, RLX_AGENT); __hip_atomic_fetch_add(cnt + e2, 1u, RLX_AGENT);
            }
        }
      }
    }
}

__device__ __forceinline__ void phase_gather(const Ctx& C, const WG& w, int mi) {
    LAS int* cl = (LAS int*)w.lds;
    LAS int* meta = cl + 2048;
    LAS int* ppos = meta + 64;
    LAS unsigned* rel = (LAS unsigned*)(ppos + 256);
    const unsigned* cnt = (const unsigned*)C.ws + CW_CNT + mi * 2048;
    for (int i = w.tid; i < 2048; i += NTHR) cl[i] = (int)__hip_atomic_load((unsigned*)cnt + i, RLX_AGENT);
    __syncthreads();
    if (w.tid < 8) { int run = 0; for (int c = 0; c < 256; ++c) { const int t = cl[c * 8 + w.tid]; cl[c * 8 + w.tid] = run; run += t; } meta[w.tid] = run; }
    __syncthreads();
    if (w.tid == 0) { int off = 0; for (int e = 0; e < 8; ++e) { meta[8 + e] = off; off += (meta[e] + 255) & ~255; } meta[16] = off; }
    __syncthreads();
    int* gmeta = (int*)(C.ws + WS_META);
    if (w.bid == 0 && w.tid < 17) gmeta[w.tid] = meta[w.tid];
    const unsigned* RE = (const unsigned*)(C.ws + WS_RE); const float* RW = (const float*)(C.ws + WS_RW);
    unsigned* POS = (unsigned*)(C.ws + WS_POS); float* WPOS = (float*)(C.ws + WS_WPOS);
    unsigned short* TOK = (unsigned short*)(C.ws + WS_TOK); const float* SA = (const float*)(C.ws + WS_SA); float* SAP = (float*)(C.ws + WS_SAP);
    for (int ch = w.bid; ch < 256; ch += w.G) {
        __syncthreads();
        if (w.tid < 128) rel[w.tid] = RE[ch * 128 + w.tid];
        __syncthreads();
        if (w.tid < 8) { const int e = w.tid; int p = meta[8 + e] + cl[ch * 8 + e];
            for (int t = 0; t < 128; ++t) { const unsigned re = rel[t]; if ((int)(re & 0xff) == e) ppos[2 * t] = p++; if ((int)(re >> 8) == e) ppos[2 * t + 1] = p++; } }
        __syncthreads();
        if (w.tid < 256) { const int t = w.tid >> 1, k = w.tid & 1; const int p = ppos[w.tid]; POS[2 * (ch * 128 + t) + k] = (unsigned)p; WPOS[p] = RW[2 * (ch * 128 + t) + k]; TOK[p] = (unsigned short)(ch * 128 + t); SAP[p] = SA[ch * 128 + t]; }
    }
    for (int e = 0; e < 8; ++e) { const int r0 = meta[8 + e] + meta[e], r1 = meta[9 + e];
        for (int r = r0 + w.bid * NTHR + w.tid; r < r1; r += w.G * NTHR) { TOK[r] = 0; WPOS[r] = 0.f; SAP[r] = 0.f; } }
}
__device__ __forceinline__ void phase_final_combine(const Ctx& C, const WG& w, int l) {
    const float* MOD = (const float*)(C.ws + WS_MOD); const bf16* OP = (const bf16*)(C.ws + WS_AS); const unsigned* POS = (const unsigned*)(C.ws + WS_POS);
    const int gw = w.bid * NWAVES + w.wave, NGW = w.G * NWAVES, lane = w.lane;
    for (int m = gw; m < MTOK; m += NGW) {
        const int b = m >> 14; const unsigned p0 = POS[2 * m], p1 = POS[2 * m + 1]; const float* g2 = MOD + (l * 2 + b) * 6144 + 5120;
#pragma unroll
        for (int j = 0; j < 4; ++j) { const v2u a = *(const v2u*)(OP + (size_t)p0 * 1024 + 4 * lane + 256 * j), bq = *(const v2u*)(OP + (size_t)p1 * 1024 + 4 * lane + 256 * j);
            const f32x4 gg = *(const f32x4*)(g2 + 4 * lane + 256 * j); const v2u xr = *(const v2u*)((const bf16*)(C.ws + WS_XB) + (size_t)m * 1024 + 4 * lane + 256 * j); const f32x4 v = {bflo(xr.x), bfhi(xr.x), bflo(xr.y), bfhi(xr.y)};
            f32x4 s; s.x = bflo(a.x) + bflo(bq.x); s.y = bfhi(a.x) + bfhi(bq.x); s.z = bflo(a.y) + bflo(bq.y); s.w = bfhi(a.y) + bfhi(bq.y);
            *(f32x4*)(C.out + (size_t)m * 1024 + 4 * lane + 256 * j) = v + gg * s; }
    }
}

constexpr int AT_K = 0, AT_V = 16384, AT_SCR = 49152, ATT_THR = 8;
__device__ __forceinline__ int crow(int r, int hi) { return (r & 3) + 8 * (r >> 2) + 4 * hi; }
__device__ __forceinline__ s16x4 vtr(const LAS unsigned char* p) { return __builtin_bit_cast(s16x4, __builtin_amdgcn_ds_read_tr16_b64_v4i16((LAS s16x4*)p)); }
__device__ __forceinline__ void attn_unit(const Ctx& C, const WG& w, int l, int b, int h, int mp, int qb, int jlo, float mref, float smax2) {
    int lane_u = w.lane; asm volatile("" : "+v"(lane_u));
    const int lane = lane_u, wid = w.wave, r32 = lane & 31, hh = lane >> 5;
    const bf16* P = (const bf16*)(C.ws + WS_PROJ);
    const size_t rowb = (size_t)b * SEQ; const int q0 = qb * 256;
    bf16x8 qf[4];
    { const bf16* qp = P + (rowb + q0 + wid * 32 + r32) * PROJ_N + C_AQ + mp * 256 + h * 64 + 8 * hh;
#pragma unroll
      for (int s = 0; s < 4; ++s) qf[s] = *(const bf16x8*)(qp + 16 * s); }
    const bf16* kp = P + (rowb + lane) * PROJ_N + C_AK + mp * 256 + h * 64 + 8 * wid;
    const bf16* vp0 = P + (rowb + 16 * (wid & 3) + (lane >> 2)) * PROJ_N + C_AV + h * 128 + 32 * (wid >> 2) + 8 * (lane & 3);
    const bf16* vp1 = vp0 + 64;
    const int kdst = AT_K + wid * 1024, vdst0 = AT_V + (wid >> 2) * 4096 + (wid & 3) * 1024, vdst1 = vdst0 + 8192;
#define AT_DMA(j, buf) do { const size_t ro = (size_t)(j) * 64 * PROJ_N; \
        __builtin_amdgcn_global_load_lds((const unsigned*)(kp + ro), (LAS unsigned*)(w.lds + (buf) * 8192 + kdst), 16, 0, 0); \
        __builtin_amdgcn_global_load_lds((const unsigned*)(vp0 + ro), (LAS unsigned*)(w.lds + (buf) * 16384 + vdst0), 16, 0, 0); \
        __builtin_amdgcn_global_load_lds((const unsigned*)(vp1 + ro), (LAS unsigned*)(w.lds + (buf) * 16384 + vdst1), 16, 0, 0); } while (0)
#define AT_WAITBAR() asm volatile("s_waitcnt vmcnt(0) lgkmcnt(0)\n\ts_barrier" ::: "memory")
    const float slope2 = exp2f(-2.0f * (float)(h + 1)) * 1.4426950408889634f;
    const int jhi = qb * 4 + 3, cw = qb * 4 + (wid >> 1);
    const int tq = q0 + wid * 32 + r32;
    f32x16 o[4];
#pragma unroll
    for (int d = 0; d < 4; ++d)
#pragma unroll
        for (int r = 0; r < 16; ++r) o[d][r] = 0.f;
    const float mrow = mref;
    f32x16 o5;
#pragma unroll
    for (int r = 0; r < 16; ++r) o5[r] = 0.f;
    const unsigned one2 = (r32 == 0) ? 0x3F803F80u : 0u; const bf16x8 vones = __builtin_bit_cast(bf16x8, (v4u){one2, one2, one2, one2});
    const int vbase = AT_V + (4 * hh + ((lane & 15) >> 2)) * 64 + ((lane >> 4) & 1) * 32 + (lane & 3) * 8;
    const int kbase = AT_K + hh * 1024 + r32 * 16;
    float scb[16];
#pragma unroll
    for (int r = 0; r < 16; ++r) scb[r] = slope2 * (float)((r & 3) + 8 * (r >> 2));
    LAS float* lmin = (LAS float*)(w.lds + AT_SCR + 2048);
    const float tailc = smax2 - mref + 6.0f - log2f(1.0f - exp2f(-64.0f * slope2)) + 32.0f;
    if (lane == 0) lmin[wid] = 0.f;
    AT_DMA(jhi, 0);
    AT_WAITBAR();
    for (int jt = jhi; jt >= jlo; --jt) {
        const int buf = (jhi - jt) & 1;
        if (jt < jhi - 3) {
            float lm = lmin[0];
#pragma unroll
            for (int k = 1; k < 8; ++k) lm = fminf(lm, lmin[k]);
            lm = __builtin_bit_cast(float, __builtin_amdgcn_readfirstlane(__builtin_bit_cast(int, lm)));
            const float dmin = (float)(q0 - 64 * jt - 63);
            if (tailc - slope2 * dmin <= log2f(lm)) break;
        }
        if (jt > jlo) AT_DMA(jt - 1, buf ^ 1);
        if (jt <= cw) {
            f32x16 p0, p1;
            if (jt < cw) {
                const float b0 = slope2 * (float)(64 * jt + 4 * hh - tq) - mrow, b1 = b0 + 32.0f * slope2;
#pragma unroll
                for (int r = 0; r < 16; ++r) { p0[r] = scb[r] + b0; p1[r] = scb[r] + b1; }
            } else {
                const float dq = (float)(tq - 64 * jt - 4 * hh);
#pragma unroll
                for (int r = 0; r < 16; ++r) { const float cr = (float)((r & 3) + 8 * (r >> 2)); p0[r] = -slope2 * fabsf(dq - cr) - mrow; p1[r] = -slope2 * fabsf(dq - cr - 32.0f) - mrow; }
            }
            const LAS unsigned char* kb = w.lds + buf * 8192 + kbase;
#pragma unroll
            for (int s = 0; s < 4; ++s) { const bf16x8 a0 = *(const LAS bf16x8*)(kb + s * 2048), a1 = *(const LAS bf16x8*)(kb + s * 2048 + 512);
                p0 = __builtin_amdgcn_mfma_f32_32x32x16_bf16(a0, qf[s], p0, 0, 0, 0); p1 = __builtin_amdgcn_mfma_f32_32x32x16_bf16(a1, qf[s], p1, 0, 0, 0); }
#pragma unroll
            for (int r = 0; r < 16; ++r) { p0[r] = fexp2(p0[r]); p1[r] = fexp2(p1[r]); }
            bf16x8 pa[4];
#pragma unroll
            for (int ks = 0; ks < 4; ++ks) { v4u t;
#pragma unroll
                for (int k = 0; k < 4; ++k) { const int r = 8 * (ks & 1) + 2 * k; t[k] = (ks < 2) ? pk2(p0[r], p0[r + 1]) : pk2(p1[r], p1[r + 1]); }
                pa[ks] = __builtin_bit_cast(bf16x8, t); }
            const LAS unsigned char* vb = w.lds + buf * 16384 + vbase;
#pragma unroll
            for (int d = 0; d < 4; ++d)
#pragma unroll
                for (int ks = 0; ks < 4; ++ks) { const s16x4 lo = vtr(vb + d * 4096 + ks * 1024), hi = vtr(vb + d * 4096 + ks * 1024 + 512);
                    const bf16x8 vf = (bf16x8){lo[0], lo[1], lo[2], lo[3], hi[0], hi[1], hi[2], hi[3]};
                    o[d] = __builtin_amdgcn_mfma_f32_32x32x16_bf16(pa[ks], vf, o[d], 0, 0, 0); }
#pragma unroll
            for (int ks = 0; ks < 4; ++ks) o5 = __builtin_amdgcn_mfma_f32_32x32x16_bf16(pa[ks], vones, o5, 0, 0, 0);
            if (jt <= jhi - 3) {
                float m = fminf(fminf(fminf(o5[0], o5[1]), fminf(o5[2], o5[3])), fminf(fminf(o5[4], o5[5]), fminf(o5[6], o5[7])));
                m = fminf(m, fminf(fminf(fminf(o5[8], o5[9]), fminf(o5[10], o5[11])), fminf(fminf(o5[12], o5[13]), fminf(o5[14], o5[15]))));
                m = fminf(__shfl(m, 0), __shfl(m, 32));
                if (lane == 0) lmin[wid] = m;
            }
        }
        AT_WAITBAR();
    }
    asm volatile("s_waitcnt vmcnt(0)" ::: "memory");
#undef AT_DMA
#undef AT_WAITBAR
    bf16* O = (bf16*)(C.ws + WS_ATTO) + (size_t)mp * MTOK * 512;
#pragma unroll
    for (int r = 0; r < 16; ++r) { const int qr = crow(r, hh); const float il = 1.0f / __shfl(o5[r], 32 * hh);
        bf16* op = O + (rowb + q0 + wid * 32 + qr) * 512 + h * 128 + r32;
#pragma unroll
        for (int d = 0; d < 4; ++d) op[d * 32] = (bf16)f2bf(o[d][r] * il); }
    __syncthreads();
}
__device__ __forceinline__ void phase_attention(const Ctx& C, const WG& w, int l, int qsel = 0) {
    float wq = fabsf(C.qn_w[l * 64 + w.lane]), wk = fabsf(C.kn_w[l * 64 + w.lane]);
#pragma unroll
    for (int o = 1; o < 64; o <<= 1) { wq = fmaxf(wq, __shfl_xor(wq, o)); wk = fmaxf(wk, __shfl_xor(wk, o)); }
    const float smax = 8.0f * wq * wk * 1.02f;
    int Wh[4];
#pragma unroll
    for (int h = 0; h < 4; ++h) { const float s = exp2f(-2.0f * (float)(h + 1)); Wh[h] = (int)ceilf((2.0f * smax + 22.180710f - logf(1.0f - expf(-s))) / s) + 1; }
    unsigned* ctr = (unsigned*)C.ws + CW_QUEUE + 64 * l + 16 * qsel;
    if (w.wave >= 4) __builtin_amdgcn_s_setprio(1);
    LAS unsigned* slot = (LAS unsigned*)(w.lds + AT_SCR + 1024);
    for (;;) {
        if (w.tid == 0) *slot = __hip_atomic_fetch_add(ctr, 1u, RLX_AGENT);
        __syncthreads();
        const int k = __builtin_amdgcn_readfirstlane((int)*slot);
        __syncthreads();
        if (k >= 1024) break;
        const int h = 3 - (k >> 8), r = k & 255, qb = 63 - (r >> 2), b = (r >> 1) & 1, mp = r & 1;
        const int Wk = h == 0 ? Wh[0] : h == 1 ? Wh[1] : h == 2 ? Wh[2] : Wh[3];
        int jlo = (qb * 256 - Wk) >> 6; jlo = jlo < 0 ? 0 : jlo;
        attn_unit(C, w, l, b, h, mp, qb, jlo, smax * 1.4426950408889634f - 16.0f, smax * 1.4426950408889634f);
    }
    __builtin_amdgcn_s_setprio(0);
}
__device__ __forceinline__ void phase_attn_combine(const Ctx& C, const WG& w, int l) {
    float s1 = 0.f, s2 = 0.f;
    { const float a = C.lq1[l * 64 + w.lane] * C.lk1[l * 64 + w.lane], c = C.lq2[l * 64 + w.lane] * C.lk2[l * 64 + w.lane]; s1 = wave_sum(a); s2 = wave_sum(c); }
    const float lam_init = 0.8f - 0.6f * expf(-0.3f * (float)l), lam = expf(s1) - expf(s2) + lam_init, post = 1.0f - lam_init;
    const bf16* O0 = (const bf16*)(C.ws + WS_ATTO); const bf16* O1 = O0 + (size_t)MTOK * 512; bf16* Y = (bf16*)(C.ws + WS_Y);
    const int gw = w.bid * NWAVES + w.wave, NGW = w.G * NWAVES, lane = w.lane;
    const float* sw = C.subln_w + l * 128 + (lane & 15) * 8; const f32x4 w0 = *(const f32x4*)sw, w1 = *(const f32x4*)(sw + 4);
    for (int m0 = gw; m0 < MTOK; m0 += 4 * NGW) {
        v4u a[4], c[4];
#pragma unroll
        for (int i = 0; i < 4; ++i) { const int m = m0 + i * NGW; if (m < MTOK) { a[i] = *(const v4u*)(O0 + (size_t)m * 512 + lane * 8); c[i] = *(const v4u*)(O1 + (size_t)m * 512 + lane * 8); } }
#pragma unroll
        for (int i = 0; i < 4; ++i) { const int m = m0 + i * NGW; if (m < MTOK) {
            float v[8]; float ss = 0.f;
#pragma unroll
            for (int k = 0; k < 4; ++k) { v[2 * k] = bflo(a[i][k]) - lam * bflo(c[i][k]); v[2 * k + 1] = bfhi(a[i][k]) - lam * bfhi(c[i][k]); ss += v[2 * k] * v[2 * k] + v[2 * k + 1] * v[2 * k + 1]; }
            ss += __shfl_xor(ss, 1); ss += __shfl_xor(ss, 2); ss += __shfl_xor(ss, 4); ss += __shfl_xor(ss, 8);
            const float sc = post / sqrtf(ss * (1.0f / 128.0f) + NORM_EPS);
            v4u o; o.x = pk2(v[0] * sc * w0.x, v[1] * sc * w0.y); o.y = pk2(v[2] * sc * w0.z, v[3] * sc * w0.w); o.z = pk2(v[4] * sc * w1.x, v[5] * sc * w1.y); o.w = pk2(v[6] * sc * w1.z, v[7] * sc * w1.w);
            *(v4u*)(Y + (size_t)m * 512 + lane * 8) = o; } }
    }
}

__device__ __forceinline__ unsigned offa(unsigned row, unsigned ch) { return 2048u * (row >> 3) + 512u * (ch >> 2) + 64u * (row & 7) + 16u * ((ch & 3) ^ ((row >> 2) & 3)); }
__device__ __forceinline__ unsigned off2(unsigned row, unsigned ch) { return 1024u * (row >> 3) + 512u * (ch >> 2) + 64u * (row & 7) + 16u * ((ch & 3) ^ ((row >> 2) & 3)); }
constexpr int S2_T0 = 0, S2_T1 = 18432, S2_T2 = 36864, S2_QT = 53248, S2_KU = 69632, S2_ATT = 86016, S2_OST = 94208, S2_AM = 126976, S2_AE = 127488, S2_KS = 128000, S2_NV = 128512, S2_CIF = 129024, S2_NS = 129536, S2_EQ = 130048, S2_EK = 130304, S2_SC = 130560;
template <int MX, int PASS>
__device__ __forceinline__ void scan_unit(const Ctx& C, const WG& w, int l, int b, int h, int seg) {
    int tid_u = w.tid; asm volatile("" : "+v"(tid_u));
    const int tid = tid_u, lane = tid_u & 63, wid = w.wave, dl = lane & 15, g4 = lane >> 4, d = wid * 16 + dl, q4 = (lane & 15) >> 2, p4 = lane & 3;
    const bf16* P = (const bf16*)(C.ws + WS_PROJ);
    const int unit = ((MX * 2 + b) * 4 + h) * 16 + seg;
    const size_t row0 = (size_t)b * SEQ + (size_t)seg * 1024;
    const int c0 = (MX == 0 ? C_BQ : C_CQ) + h * 128, c1 = (MX == 0 ? C_BF : C_CK) + h * 128, c2 = (MX == 0 ? C_BI : C_CV) + h * 128, c3 = (MX == 0 ? C_BG : C_CO) + h * 128;
    constexpr int HALO = MX == 0 ? 0 : 4;
    LAS unsigned char* const L = w.lds;
#define TRB(fn, r0, cc) (fn((unsigned)((r0) + q4), (unsigned)((cc) + (p4 >> 1))) + 8u * (unsigned)(p4 & 1))
    float lbv = 0.f, cwq[4], cwk[4], cbq = 0.f, cbk = 0.f, ibv = 0.f, fbv = 0.f;
    if (MX == 0) { float e[4], s = 0.f, mx = -INFINITY;
#pragma unroll
        for (int k = 0; k < 4; ++k) { e[k] = C.lb_logits[k * 512 + h * 128 + d]; mx = fmaxf(mx, e[k]); }
#pragma unroll
        for (int k = 0; k < 4; ++k) { e[k] = expf(e[k] - mx); s += e[k]; }
        float acc = 0.f;
#pragma unroll
        for (int k = 1; k < 4; ++k) if (k <= l) acc += e[k];
        lbv = acc / s;
    } else {
#pragma unroll
        for (int k = 0; k < 4; ++k) { cwq[k] = C.conv_w[(l * 4 + k) * 1024 + h * 128 + d]; cwk[k] = C.conv_w[(l * 4 + k) * 1024 + 512 + h * 128 + d]; }
        cbq = C.conv_b[l * 1024 + h * 128 + d]; cbk = C.conv_b[l * 1024 + 512 + h * 128 + d]; ibv = C.ig_b[l * 4 + h]; fbv = C.fg_b[l * 4 + h];
    }
    f32x4 S[8];
#pragma unroll
    for (int i = 0; i < 8; ++i) S[i] = (f32x4){0.f, 0.f, 0.f, 0.f};
    float bsum = 0.f;
    const f32x4* STS = (const f32x4*)(C.ws + WS_STS); const float* STA = (const float*)(C.ws + WS_STA); const float* STN = (const float*)(C.ws + WS_STN);
    LAS float* NV = (LAS float*)(L + S2_NV);
    {
        float nacc = 0.f;
        if (PASS == 2) {
            for (int j = 0; j < seg; j += 2) {
                const int uj = unit - seg + j; const bool two = j + 1 < seg; const int uk = two ? uj + 1 : uj;
                f32x4 a0[8], e0[8], a1[8], e1[8];
#pragma unroll
                for (int i = 0; i < 8; ++i) { a0[i] = *(const f32x4*)(STA + uj * 128 + 16 * i + 4 * g4); e0[i] = STS[((size_t)(uj * 8 + wid) * 8 + i) * 64 + lane]; }
#pragma unroll
                for (int i = 0; i < 8; ++i) { a1[i] = *(const f32x4*)(STA + uk * 128 + 16 * i + 4 * g4); e1[i] = STS[((size_t)(uk * 8 + wid) * 8 + i) * 64 + lane]; }
                float na0 = 0.f, ne0 = 0.f, na1 = 0.f, ne1 = 0.f;
                if (MX == 1) { na0 = STA[uj * 128 + d]; ne0 = STN[uj * 128 + d]; na1 = STA[uk * 128 + d]; ne1 = STN[uk * 128 + d]; }
#pragma unroll
                for (int i = 0; i < 8; ++i) { S[i] = a0[i] * S[i] + e0[i]; if (two) S[i] = a1[i] * S[i] + e1[i]; }
                if (MX == 1) { nacc = na0 * nacc + ne0; if (two) nacc = na1 * nacc + ne1; } }
        }
        if (g4 == 0) NV[d] = nacc;
    }
    v4u ra0, ra1, rb0, rb1, rc0, rc1, gq0, gq1; float rgc = 0.f;
    const float* CIF = (const float*)(C.ws + WS_CIF);
#define S2_LOAD01(st) do { const size_t t0_ = row0 + (size_t)(st) * 64; \
        ra0 = *(const v4u*)(P + (t0_ + (tid >> 4)) * PROJ_N + c0 + (tid & 15) * 8); rb0 = *(const v4u*)(P + (t0_ + (tid >> 4)) * PROJ_N + c1 + (tid & 15) * 8); \
        ra1 = *(const v4u*)(P + (t0_ + 32 + (tid >> 4)) * PROJ_N + c0 + (tid & 15) * 8); rb1 = *(const v4u*)(P + (t0_ + 32 + (tid >> 4)) * PROJ_N + c1 + (tid & 15) * 8); \
        if (MX == 1 && tid < 128) rgc = CIF[(t0_ + (tid >> 1)) * 8 + h + 4 * (tid & 1)]; } while (0)
#define S2_LOAD2(st) do { const size_t t0_ = row0 + (size_t)(st) * 64; \
        rc0 = *(const v4u*)(P + (t0_ + (tid >> 4)) * PROJ_N + c2 + (tid & 15) * 8); rc1 = *(const v4u*)(P + (t0_ + 32 + (tid >> 4)) * PROJ_N + c2 + (tid & 15) * 8); } while (0)
#define S2_STORE01(carry) do { \
        if ((carry) && HALO != 0 && tid >= 448) { const unsigned src_ = offa(HALO + 32 + (tid >> 4), tid & 15), dst_ = offa((tid >> 4) - 28, tid & 15); \
            const v4u o0_ = *(const LAS v4u*)(L + S2_T0 + src_), o1_ = *(const LAS v4u*)(L + S2_T1 + src_); *(LAS v4u*)(L + S2_T0 + dst_) = o0_; *(LAS v4u*)(L + S2_T1 + dst_) = o1_; } \
        *(LAS v4u*)(L + S2_T0 + offa(HALO + (tid >> 4), tid & 15)) = ra0; *(LAS v4u*)(L + S2_T1 + offa(HALO + (tid >> 4), tid & 15)) = rb0; \
        *(LAS v4u*)(L + S2_T0 + offa(HALO + 32 + (tid >> 4), tid & 15)) = ra1; *(LAS v4u*)(L + S2_T1 + offa(HALO + 32 + (tid >> 4), tid & 15)) = rb1; \
        if (MX == 1 && tid < 128) *(LAS float*)(L + S2_CIF + tid * 4) = rgc; } while (0)
#define S2_STORE2() do { *(LAS v4u*)(L + S2_T2 + offa(tid >> 4, tid & 15)) = rc0; *(LAS v4u*)(L + S2_T2 + offa((tid >> 4) + 32, tid & 15)) = rc1; } while (0)
    if (HALO != 0 && tid < 64) {
        const long tr = (long)row0 + (tid >> 4) - HALO; const bool ok = tr >= (long)((size_t)b * SEQ);
        *(LAS v4u*)(L + S2_T0 + offa(tid >> 4, tid & 15)) = ok ? *(const v4u*)(P + (size_t)tr * PROJ_N + c0 + (tid & 15) * 8) : (v4u){0u, 0u, 0u, 0u};
        *(LAS v4u*)(L + S2_T1 + offa(tid >> 4, tid & 15)) = ok ? *(const v4u*)(P + (size_t)tr * PROJ_N + c1 + (tid & 15) * 8) : (v4u){0u, 0u, 0u, 0u};
    }
    __syncthreads();
    const int lane_s = lane;
#define SC_BAR() asm volatile("s_waitcnt lgkmcnt(0)\n\ts_barrier" ::: "memory")
#define S2_SCAL() do { if (MX == 1 && wid == 0) { const int t_ = lane_s; const f32x2 cf_ = *(const LAS f32x2*)(L + S2_CIF + t_ * 8); \
        float b_ = -flog(1.f + fexp(-(cf_.y + fbv))); \
        b_ += dppf<0x111>(0.f, b_); b_ += dppf<0x112>(0.f, b_); b_ += dppf<0x114>(0.f, b_); b_ += dppf<0x118>(0.f, b_);            \
        b_ += dppf<0x142, 0xA>(0.f, b_); b_ += dppf<0x143, 0xC>(0.f, b_);                                                        \
        const float bm_ = __builtin_bit_cast(float, __builtin_amdgcn_readlane(__builtin_bit_cast(int, b_), 31)), be_ = __builtin_bit_cast(float, __builtin_amdgcn_readlane(__builtin_bit_cast(int, b_), 63)); \
        *(LAS float*)(L + S2_EQ + t_ * 4) = fexp(b_ - bm_); *(LAS float*)(L + S2_EK + t_ * 4) = fexp(bm_ - b_ + cf_.x + ibv); \
        if (t_ == 0) *(LAS f32x4*)(L + S2_SC) = (f32x4){fexp(bm_), fexp(be_ - bm_), be_, 0.f}; } } while (0)
    S2_LOAD01(0); S2_LOAD2(0); S2_STORE01(false); S2_STORE2();
    __syncthreads();
    S2_SCAL();
    __syncthreads();
    bf16* Y = (bf16*)(C.ws + WS_Y) + (size_t)(MX == 0 ? 1 : 2) * MTOK * 512;
    const float* nwp = (MX == 0 ? C.gnorm_w : C.cnorm_w) + l * 128;
    for (int st = 0; st < 16; ++st) {
        if (PASS == 1 && st < 15) { S2_LOAD01(st + 1); S2_LOAD2(st + 1); }
#ifndef SCAN_PREP_REP
#define SCAN_PREP_REP 1
#endif
        for (int prep_rep = 0; prep_rep < SCAN_PREP_REP; ++prep_rep) {
            int ln_ = lane; if (MX == 1 && PASS == 2) asm volatile("" : "+v"(ln_));
            const int dl = ln_ & 15, g4 = ln_ >> 4, d = wid * 16 + dl, q4 = (ln_ & 15) >> 2, p4 = ln_ & 3; (void)d; (void)q4; (void)p4; (void)g4;
            float lf[16], qv[16], kv[16];
            if (MX == 0) {
#pragma unroll
                for (int j = 0; j < 4; ++j) { const s16x4 qr = vtr(L + S2_T0 + TRB(offa, 16 * g4 + 4 * j, 2 * wid)), fr = vtr(L + S2_T1 + TRB(offa, 16 * g4 + 4 * j, 2 * wid));
#pragma unroll
                    for (int e = 0; e < 4; ++e) { const float q = bf2f((unsigned)(unsigned short)qr[e]), f = bf2f((unsigned)(unsigned short)fr[e]);
                        const float ex = fexp(-f), sg = frcp(1.f + ex);
                        lf[4 * j + e] = flog(lbv + (1.f - lbv) * sg); kv[4 * j + e] = (1.f - lbv) * ex * sg; qv[4 * j + e] = q * fsigmoid(q); } }
            } else {
                f32x2 u2[20];
#pragma unroll
                for (int j = 0; j < 5; ++j) { const s16x4 qr = vtr(L + S2_T0 + TRB(offa, 16 * g4 + 4 * j, 2 * wid)), kr = vtr(L + S2_T1 + TRB(offa, 16 * g4 + 4 * j, 2 * wid));
#pragma unroll
                    for (int e = 0; e < 4; ++e) u2[4 * j + e] = (f32x2){bf2f((unsigned)(unsigned short)qr[e]), bf2f((unsigned)(unsigned short)kr[e])}; }
                const f32x2 cb2 = {cbq, cbk}, cw2[4] = {{cwq[0], cwk[0]}, {cwq[1], cwk[1]}, {cwq[2], cwk[2]}, {cwq[3], cwk[3]}};
#pragma unroll
                for (int k = 0; k < 16; ++k) { f32x2 a2 = cb2;
#pragma unroll
                    for (int c = 0; c < 4; ++c) a2 = a2 + cw2[c] * u2[k + 1 + c];
                    const float aq = a2.x, ak = a2.y;
                    qv[k] = aq * fsigmoid(aq); kv[k] = ak * fsigmoid(ak) * 0.08838834764831845f;
                    lf[k] = 0.f; }
            }
            float cs[16]; cs[0] = lf[0];
#pragma unroll
            for (int k = 1; k < 16; ++k) cs[k] = cs[k - 1] + lf[k];
            const float t0 = __shfl(cs[15], dl), t1 = __shfl(cs[15], dl + 16), t2 = __shfl(cs[15], dl + 32), t3 = __shfl(cs[15], dl + 48);
            const float bm = t0 + t1, bend = bm + (t2 + t3);
            const float off = (g4 == 0 ? 0.f : g4 == 1 ? t0 : g4 == 2 ? bm : bm + t2) - bm;
            float qb16[16], kb16[16]; float ksl = 0.f;
            if (MX == 1) {
#pragma unroll
                for (int k4 = 0; k4 < 4; ++k4) { const f32x4 eq = *(const LAS f32x4*)(L + S2_EQ + (16 * g4 + 4 * k4) * 4), ek = *(const LAS f32x4*)(L + S2_EK + (16 * g4 + 4 * k4) * 4);
#pragma unroll
                    for (int e = 0; e < 4; ++e) { const int k = 4 * k4 + e; const float ku = kv[k] * ek[e]; ksl += ku; kb16[k] = ku; qb16[k] = qv[k] * eq[e]; } }
            } else {
#pragma unroll
            for (int k = 0; k < 16; ++k) { const float bj = off + cs[k]; const float ku = kv[k] * fexp(-bj); ksl += ku; kb16[k] = ku; qb16[k] = qv[k] * fexp(bj); }
            }
            if (PASS == 2) { *(LAS v4u*)(L + S2_QT + off2(d, 2 * g4)) = (v4u){pk2(qb16[0], qb16[1]), pk2(qb16[2], qb16[3]), pk2(qb16[4], qb16[5]), pk2(qb16[6], qb16[7])};
                             *(LAS v4u*)(L + S2_QT + off2(d, 2 * g4 + 1)) = (v4u){pk2(qb16[8], qb16[9]), pk2(qb16[10], qb16[11]), pk2(qb16[12], qb16[13]), pk2(qb16[14], qb16[15])}; }
            *(LAS v4u*)(L + S2_KU + off2(d, 2 * g4)) = (v4u){pk2(kb16[0], kb16[1]), pk2(kb16[2], kb16[3]), pk2(kb16[4], kb16[5]), pk2(kb16[6], kb16[7])};
            *(LAS v4u*)(L + S2_KU + off2(d, 2 * g4 + 1)) = (v4u){pk2(kb16[8], kb16[9]), pk2(kb16[10], kb16[11]), pk2(kb16[12], kb16[13]), pk2(kb16[14], kb16[15])};
            if (MX == 1) { ksl += __shfl_xor(ksl, 16); ksl += __shfl_xor(ksl, 32); }
            const f32x4 scl_ = MX == 1 ? *(const LAS f32x4*)(L + S2_SC) : (f32x4){0.f, 0.f, 0.f, 0.f};
            if (g4 == 0) { *(LAS float*)(L + S2_AM + d * 4) = MX == 1 ? scl_.x : fexp(bm); *(LAS float*)(L + S2_AE + d * 4) = MX == 1 ? scl_.y : fexp(bend - bm); if (MX == 1) { *(LAS float*)(L + S2_KS + d * 4) = ksl; if (prep_rep == 0) *(LAS float*)(L + S2_NS + d * 4) = scl_.x * NV[d]; } }
            if (prep_rep == 0) bsum += (MX == 1 ? scl_.z : bend);
        }
        if (PASS == 2 && st < 15) S2_LOAD01(st + 1);
        SC_BAR();
        if (PASS == 2) {
            int ln_ = lane; if (MX == 1 && PASS == 2) asm volatile("" : "+v"(ln_));
            const int dl = ln_ & 15, g4 = ln_ >> 4, d = wid * 16 + dl, q4 = (ln_ & 15) >> 2, p4 = ln_ & 3; (void)d; (void)q4; (void)p4; (void)g4;
            const unsigned cA0 = 1024u * g4 + 64u * q4 + 8u * (p4 & 1) + 16u * (unsigned)(p4 >> 1), cA1 = 1024u * g4 + 256u + 64u * q4 + 8u * (p4 & 1) + 16u * (unsigned)((p4 >> 1) ^ 1);
            const unsigned xs = (unsigned)((dl >> 2) & 3), cS = 1024u * (dl >> 3) + 64u * (dl & 7) + 8u * (g4 & 1) + 16u * (unsigned)((g4 >> 1) ^ (xs & 1));
#pragma unroll
            for (int rep = 0; rep < 2; ++rep) { const int ti = wid + 8 * rep;
                if (ti < 10) { const int tt = ti < 1 ? 0 : ti < 3 ? 1 : ti < 6 ? 2 : 3, ts = ti - (tt * (tt + 1)) / 2;
                    const unsigned kofs = 32u * (unsigned)((ts & 1) ^ (g4 & 1)) + 512u * (unsigned)(ts >> 1), qofs = 32u * (unsigned)((tt & 1) ^ (g4 & 1)) + 512u * (unsigned)(tt >> 1);
                    const LAS unsigned char* ka0 = L + S2_KU + cA0 + kofs; const LAS unsigned char* ka1 = L + S2_KU + cA1 + kofs;
                    const LAS unsigned char* qa0 = L + S2_QT + cA0 + qofs; const LAS unsigned char* qa1 = L + S2_QT + cA1 + qofs;
                    f32x4 at = (f32x4){0.f, 0.f, 0.f, 0.f};
#pragma unroll
                    for (int kk = 0; kk < 4; ++kk) { const s16x4 a0 = vtr(ka0 + 4096 * kk), a1 = vtr(ka1 + 4096 * kk), b0 = vtr(qa0 + 4096 * kk), b1 = vtr(qa1 + 4096 * kk);
                        at = __builtin_amdgcn_mfma_f32_16x16x32_bf16((bf16x8){a0[0], a0[1], a0[2], a0[3], a1[0], a1[1], a1[2], a1[3]}, (bf16x8){b0[0], b0[1], b0[2], b0[3], b1[0], b1[1], b1[2], b1[3]}, at, 0, 0, 0); }
                    if (ts == tt) {
#pragma unroll
                        for (int r = 0; r < 4; ++r) at[r] = (4 * g4 + r <= dl) ? at[r] : 0.f; }
                    LAS unsigned char* sp = L + S2_ATT + cS + 2048u * (unsigned)tt;
                    *(LAS v2u*)(sp + 32u * (unsigned)((ts & 1) ^ (xs >> 1)) + 512u * (unsigned)(ts >> 1)) = (v2u){pk2(at[0], at[1]), pk2(at[2], at[3])};
                    if (ts == tt && (tt & 1) == 0) *(LAS v2u*)(sp + 32u * (unsigned)(((ts + 1) & 1) ^ (xs >> 1)) + 512u * (unsigned)((ts + 1) >> 1)) = (v2u){0u, 0u};
                } }
        }
        SC_BAR();
        {
            int ln_ = lane; if (MX == 1 && PASS == 2) asm volatile("" : "+v"(ln_));
            const int dl = ln_ & 15, g4 = ln_ >> 4, d = wid * 16 + dl, q4 = (ln_ & 15) >> 2, p4 = ln_ & 3; (void)d; (void)q4; (void)p4; (void)g4;
#pragma unroll
            for (int i = 0; i < 8; ++i) S[i] = S[i] * *(const LAS f32x4*)(L + S2_AM + (16 * i + 4 * g4) * 4);
            bf16x8 vfr[2];
            const unsigned cE = 2048u * g4 + 512u * (unsigned)(wid >> 1) + 64u * q4 + 8u * (p4 & 1) + 32u * (unsigned)((wid & 1) ^ (g4 & 1));
            const LAS unsigned char* ve0 = L + S2_T2 + cE + 16u * (unsigned)(p4 >> 1); const LAS unsigned char* ve1 = L + S2_T2 + cE + 256u + 16u * (unsigned)((p4 >> 1) ^ 1);
            const unsigned cC = 1024u * (dl >> 3) + 64u * (dl & 7) + 16u * (unsigned)(g4 ^ ((dl >> 2) & 3));
            const unsigned cB = 1024u * (g4 >> 1) + 256u * (g4 & 1) + 64u * q4 + 8u * (p4 & 1) + 16u * (unsigned)((p4 >> 1) ^ (g4 & 1));
#pragma unroll
            for (int ks = 0; ks < 2; ++ks) { const s16x4 v0 = vtr(ve0 + 8192 * ks), v1 = vtr(ve1 + 8192 * ks);
                vfr[ks] = (bf16x8){v0[0], v0[1], v0[2], v0[3], v1[0], v1[1], v1[2], v1[3]}; }
            if (PASS == 2 && st < 15) S2_LOAD2(st + 1);
            if (PASS == 2) { const size_t grow_ = row0 + (size_t)st * 64 + (tid >> 3); gq0 = *(const v4u*)(P + grow_ * PROJ_N + c3 + (tid & 7) * 16); gq1 = *(const v4u*)(P + grow_ * PROJ_N + c3 + (tid & 7) * 16 + 8); }
            if (PASS == 2) {
                bf16x8 sfr[4];
#pragma unroll
                for (int kk = 0; kk < 4; ++kk) sfr[kk] = __builtin_bit_cast(bf16x8, (v4u){pk2(S[2 * kk][0], S[2 * kk][1]), pk2(S[2 * kk][2], S[2 * kk][3]), pk2(S[2 * kk + 1][0], S[2 * kk + 1][1]), pk2(S[2 * kk + 1][2], S[2 * kk + 1][3])});
                bf16x8 nfr[4], onesf;
                if (MX == 1) {
#pragma unroll
                    for (int kk = 0; kk < 4; ++kk) { const f32x4 n0 = *(const LAS f32x4*)(L + S2_NS + (32 * kk + 4 * g4) * 4), n1 = *(const LAS f32x4*)(L + S2_NS + (32 * kk + 16 + 4 * g4) * 4);
                        nfr[kk] = dl == 0 ? __builtin_bit_cast(bf16x8, (v4u){pk2(n0.x, n0.y), pk2(n0.z, n0.w), pk2(n1.x, n1.y), pk2(n1.z, n1.w)}) : __builtin_bit_cast(bf16x8, (v4u){0u, 0u, 0u, 0u}); }
                    const unsigned o2 = dl == 0 ? 0x3F803F80u : 0u; onesf = __builtin_bit_cast(bf16x8, (v4u){o2, o2, o2, o2});
                }
#pragma unroll 2
                for (int tt = 0; tt < 4; ++tt) {
                    f32x4 O = (f32x4){0.f, 0.f, 0.f, 0.f}, dacc = (f32x4){0.f, 0.f, 0.f, 0.f};
                    const LAS unsigned char* qb = L + S2_QT + cB + 32u * (unsigned)((tt & 1) ^ (g4 >> 1)) + 512u * (unsigned)(tt >> 1);
#pragma unroll
                    for (int kk = 0; kk < 4; ++kk) { const s16x4 a0 = vtr(qb + 4096 * kk), a1 = vtr(qb + 4096 * kk + 2048);
                        const bf16x8 qa = (bf16x8){a0[0], a0[1], a0[2], a0[3], a1[0], a1[1], a1[2], a1[3]};
                        O = __builtin_amdgcn_mfma_f32_16x16x32_bf16(qa, sfr[kk], O, 0, 0, 0);
                        if (MX == 1) dacc = __builtin_amdgcn_mfma_f32_16x16x32_bf16(qa, nfr[kk], dacc, 0, 0, 0); }
#pragma unroll
                    for (int ks = 0; ks < 2; ++ks) if (ks <= (tt >> 1)) { const v4u ar = *(const LAS v4u*)(L + S2_ATT + cC + 2048u * (unsigned)tt + 512u * (unsigned)ks);
                        O = __builtin_amdgcn_mfma_f32_16x16x32_bf16(__builtin_bit_cast(bf16x8, ar), vfr[ks], O, 0, 0, 0);
                        if (MX == 1) dacc = __builtin_amdgcn_mfma_f32_16x16x32_bf16(__builtin_bit_cast(bf16x8, ar), onesf, dacc, 0, 0, 0); }
                    if (MX == 1) {
#pragma unroll
                        for (int r = 0; r < 4; ++r) O[r] *= __shfl(1.0f / fmaxf(fabsf(dacc[r]), 1.0f), 16 * g4); }
#pragma unroll
                    for (int r = 0; r < 4; ++r) *(LAS float*)(L + S2_OST + (16 * tt + 4 * g4 + r) * 512 + d * 4) = O[r];
                }
            }
            if (st < 15) S2_STORE01(true);
#pragma unroll
            for (int i = 0; i < 8; ++i) {
#pragma unroll
                for (int ks = 0; ks < 2; ++ks) { const v4u kr = *(const LAS v4u*)(L + S2_KU + cC + 2048 * i + 512 * ks); S[i] = __builtin_amdgcn_mfma_f32_16x16x32_bf16(__builtin_bit_cast(bf16x8, kr), vfr[ks], S[i], 0, 0, 0); }
                S[i] = S[i] * *(const LAS f32x4*)(L + S2_AE + (16 * i + 4 * g4) * 4); }
        }
        SC_BAR();
        if (st < 15) S2_STORE2();
        if (st < 15) S2_SCAL();
        { int ln_ = lane; const int dl = ln_ & 15, g4 = ln_ >> 4, d = wid * 16 + dl;
        if (MX == 1 && g4 == 0) NV[d] = *(const LAS float*)(L + S2_AE + d * 4) * (*(const LAS float*)(L + S2_AM + d * 4) * NV[d] + *(const LAS float*)(L + S2_KS + d * 4));
        }
        if (PASS == 2) {
            int tl_ = tid;
            const int t = tl_ >> 3, cb = tl_ & 7; const size_t grow = row0 + (size_t)st * 64 + t;
            const v4u g0 = gq0, g1 = gq1;
            f32x4 ov[4]; float ss = 0.f;
#pragma unroll
            for (int k = 0; k < 4; ++k) { ov[k] = *(const LAS f32x4*)(L + S2_OST + t * 512 + (cb * 16 + 4 * k) * 4); ss += (ov[k].x * ov[k].x + ov[k].y * ov[k].y) + (ov[k].z * ov[k].z + ov[k].w * ov[k].w); }
            ss += __shfl_xor(ss, 1); ss += __shfl_xor(ss, 2); ss += __shfl_xor(ss, 4);
            const float rstd = 1.0f / sqrtf(ss * (1.0f / 128.0f) + NORM_EPS);
            float gt[16] = {bflo(g0.x), bfhi(g0.x), bflo(g0.y), bfhi(g0.y), bflo(g0.z), bfhi(g0.z), bflo(g0.w), bfhi(g0.w), bflo(g1.x), bfhi(g1.x), bflo(g1.y), bfhi(g1.y), bflo(g1.z), bfhi(g1.z), bflo(g1.w), bfhi(g1.w)};
            float ov16[16];
#pragma unroll
            for (int k = 0; k < 4; ++k) { const f32x4 nwv = *(const f32x4*)(nwp + cb * 16 + 4 * k);
#pragma unroll
                for (int e = 0; e < 4; ++e) { const float gg = gt[4 * k + e]; ov16[4 * k + e] = ov[k][e] * rstd * nwv[e] * ((MX == 0) ? gg * fsigmoid(gg) : fsigmoid(gg)); } }
            v4u o0, o1; o0.x = pk2(ov16[0], ov16[1]); o0.y = pk2(ov16[2], ov16[3]); o0.z = pk2(ov16[4], ov16[5]); o0.w = pk2(ov16[6], ov16[7]);
            o1.x = pk2(ov16[8], ov16[9]); o1.y = pk2(ov16[10], ov16[11]); o1.z = pk2(ov16[12], ov16[13]); o1.w = pk2(ov16[14], ov16[15]);
            *(v4u*)(Y + grow * 512 + h * 128 + cb * 16) = o0; *(v4u*)(Y + grow * 512 + h * 128 + cb * 16 + 8) = o1;
        }
        SC_BAR();
    }
#undef SC_BAR
#undef S2_SCAL
#undef S2_LOAD01
#undef S2_LOAD2
#undef S2_STORE01
#undef S2_STORE2
#undef TRB
    if (PASS == 1) {
        f32x4* STSw = (f32x4*)(C.ws + WS_STS);
#pragma unroll
        for (int i = 0; i < 8; ++i) STSw[((size_t)(unit * 8 + wid) * 8 + i) * 64 + lane] = S[i];
        if (g4 == 0) { ((float*)(C.ws + WS_STA))[unit * 128 + d] = fexp(bsum); ((float*)(C.ws + WS_STN))[unit * 128 + d] = (MX == 1) ? NV[d] : 0.f; }
    }
    __syncthreads();
}
template <int PASS>
__device__ __forceinline__ void phase_scan(const Ctx& C, const WG& w, int l) {
    for (int u = w.bid; u < 256; u += w.G) {
        const int seg = u & 15, h = (u >> 4) & 3, b = (u >> 6) & 1;
        if (u < 128) scan_unit<0, PASS>(C, w, l, b, h, seg); else scan_unit<1, PASS>(C, w, l, b, h, seg);
    }
}

constexpr int NPHASE = 1 + DEPTH * 11 - DEPTH / 2 + 1;
#ifndef REP_PH
#define REP_PH -1
#endif
#define REP(k, ...) do { __VA_ARGS__; if (REP_PH == (k)) { __syncthreads(); __VA_ARGS__; } } while (0)
struct Args { const float* in[31]; float* out; unsigned char* ws; int ph_lo, ph_hi; };
__device__ __forceinline__ int opaque_zero() { int z; asm volatile("s_mov_b32 %0, 0" : "=s"(z)); return z; }
#define MKC() WG w; { int t_ = TIDNOW(); asm volatile("" : "+v"(t_)); w.lds = (LAS unsigned char*)lds_raw; w.tid = t_; w.lane = t_ & 63; w.wave = wave0; w.G = gridDim.x; w.bid = blockIdx.x; asm volatile("" : "+s"(w.wave), "+s"(w.G), "+s"(w.bid)); } \
    Ctx C; { const int z_ = opaque_zero(); \
    C.x = args.in[0 + z_]; C.c = args.in[1 + z_]; C.w_mod = args.in[2 + z_]; C.b_mod = args.in[3 + z_]; C.norm1_w = args.in[4 + z_]; C.norm2_w = args.in[5 + z_]; C.w_in = args.in[6 + z_]; C.conv_w = args.in[7 + z_]; C.conv_b = args.in[8 + z_]; \
    C.qn_w = args.in[9 + z_]; C.kn_w = args.in[10 + z_]; C.lq1 = args.in[11 + z_]; C.lk1 = args.in[12 + z_]; C.lq2 = args.in[13 + z_]; C.lk2 = args.in[14 + z_]; C.subln_w = args.in[15 + z_]; C.lb_logits = args.in[16 + z_]; C.gnorm_w = args.in[17 + z_]; \
    C.ig_b = args.in[18 + z_]; C.fg_b = args.in[19 + z_]; C.cnorm_w = args.in[20 + z_]; C.w_branch = args.in[21 + z_]; C.w_out = args.in[22 + z_]; C.ffn_w1 = args.in[23 + z_]; C.ffn_w3 = args.in[24 + z_]; C.ffn_w2 = args.in[25 + z_]; \
    C.router_w = args.in[26 + z_]; C.router_b = args.in[27 + z_]; C.moe_w1 = args.in[28 + z_]; C.moe_w3 = args.in[29 + z_]; C.moe_w2 = args.in[30 + z_]; C.out = args.out; C.ws = args.ws; asm volatile("" : "+s"(C.ws), "+s"(C.out)); }
__global__ void __launch_bounds__(NTHR, 2) fwd_kernel(Args args) {
    extern __shared__ __attribute__((aligned(16))) unsigned char lds_raw[];
    const int wave0 = __builtin_amdgcn_readfirstlane((int)threadIdx.x >> 6);
#define TIDNOW() (wave0 * 64 + lane_now())
    unsigned char* const wsb = args.ws;
    for (int u = TIDNOW(); u < (LDS_BYTES - RING_BYTES) / 4; u += NTHR) ((LAS unsigned*)((LAS unsigned char*)lds_raw + RING_BYTES))[u] = 0u;
    __syncthreads();
    volatile LAS unsigned* MISC = (volatile LAS unsigned*)((LAS unsigned char*)lds_raw + MISC_OFF);
    XcdBarrier bar; bar.bar = (unsigned*)wsb + CW_BAR; bar.x = 0; bar.st = nullptr;
    const int lo = args.ph_lo, hi = args.ph_hi;
    if (hi - lo > 1) bar = xcd_barrier_post((unsigned*)wsb + CW_BAR, MISC + 8, TIDNOW() == 0);
    int ph = 0;
#define PH_RUN (ph >= lo && ph < hi)
#define PH_END do { if (PH_RUN && ph + 1 < hi) xcd_barrier(bar, TIDNOW() == 0); ++ph; } while (0)
#define H ((bf16*)(C.ws + WS_H))
#define PROJ ((bf16*)(C.ws + WS_PROJ))
#define MOD ((const float*)(C.ws + WS_MOD))

    if (PH_RUN) { MKC(); REP(0, phase_prologue(C, w)); }
    PH_END;
    for (int l = 0; l < DEPTH; ++l) {
        const bool moe = (l & 1) != 0;
        if (PH_RUN) { MKC(); if (l == 0) { phase_cvt_qwin(C, w); phase_cvt_q13d(C, w); __syncthreads(); }
            phase_norm<0>(C, w, l, l > 0 && ((l - 1) & 1) != 0); if (REP_PH == 1 && !(l > 0 && ((l - 1) & 1) != 0)) { __syncthreads(); phase_norm<0>(C, w, l, false); } }
        PH_END;
        if (PH_RUN) { MKC(); pg8::Gemm g{H, (const bf16*)(C.ws + WS_WIN + (size_t)l * WIN_ROWS * 1024), MTOK, WIN_ROWS, 512}; pg8::StaticOrder S; S.init(MTOK, WIN_ROWS, w.G, w.bid);
            pg8::EpiProj E{PROJ, C.qn_w + l * 64, C.kn_w + l * 64, (unsigned char*)(C.ws + WS_GATE8), (const float*)(C.ws + WS_SA), (const float*)C.ws + CM_WIN + l * WIN_ROWS}; REP(2, (pg8::gemm_phase<pg8::EpiProj, pg8::StaticOrder, true, true>(w.lds, g, S, E, w.tid))); }
        PH_END;
        if (PH_RUN) { MKC(); REP(3, phase_scan<1>(C, w, l)); }
        PH_END;
        if (PH_RUN) { MKC(); REP(4, phase_scan<2>(C, w, l)); phase_attention(C, w, l); if (REP_PH == 5) { __syncthreads(); phase_attention(C, w, l, 1); } }
        PH_END;
        if (PH_RUN) { MKC(); REP(6, phase_attn_combine(C, w, l)); }
        PH_END;
        if (PH_RUN) { MKC();
            pg8::StaticOrder S; S.init(MTOK, 1024, w.G, w.bid);
            const bf16* Y = (const bf16*)(C.ws + WS_Y); const bf16* WB = (const bf16*)(C.ws + WS_WBR) + (size_t)l * 3 * 1024 * 512;
            { pg8::MergeOrder MS; MS.S = S; pg8::Gemm g{Y, WB, MTOK, 1024, 512}; pg8::EpiMergeChain E{(const unsigned char*)(C.ws + WS_GATE8), H};
              REP(7, (pg8::gemm_phase<pg8::EpiMergeChain, pg8::MergeOrder, true, true>(w.lds, g, MS, E, w.tid))); }
        }
        PH_END;
        if (PH_RUN) { MKC(); pg8::Gemm g{H, (const bf16*)(C.ws + WS_WOUT) + (size_t)l * 1024 * 1024, MTOK, 1024, 1024}; pg8::StaticOrder S; S.init(MTOK, 1024, w.G, w.bid);
            pg8::EpiResid E{l == 0 ? C.x : nullptr, (bf16*)(C.ws + WS_XB), MOD + (size_t)l * 2 * 6144 + 2048}; pg8::gemm_phase<pg8::EpiResid, pg8::StaticOrder, true, true>(w.lds, g, S, E, w.tid); }
        PH_END;
        if (PH_RUN) { MKC(); if (moe) { phase_norm<2>(C, w, l, false); amx_run(C, w, 1 + (l >> 1)); } else { REP(13, phase_norm<1>(C, w, l, false)); } }
        PH_END;
        if (moe) { if (PH_RUN) { MKC(); REP(12, phase_gather(C, w, l >> 1)); __syncthreads(); REP(11, phase_cvt_moe(C, w, l >> 1)); }
            PH_END; }
        if (PH_RUN) { MKC();
            if (!moe) { pg8::StaticOrder S; S.init(MTOK, 5632, w.G, w.bid);
#if I8_DENSE == 1
                pg8::Gemm g{H, (const bf16*)(C.ws + WS_W13D + (size_t)(l >> 1) * 5632 * 1024), MTOK, 5632, 512};
                pg8::EpiSwiglu E{(bf16*)(C.ws + WS_U), (const float*)(C.ws + WS_SA), (const float*)C.ws + CM_W13D + (l >> 1) * 5632}; REP(9, (pg8::gemm_phase<pg8::EpiSwiglu, pg8::StaticOrder, true, true>(w.lds, g, S, E, w.tid)));
#else
                pg8::Gemm g{H, (const bf16*)(C.ws + WS_W13D) + (size_t)(l >> 1) * 5632 * 1024, MTOK, 5632, 1024};
                pg8::EpiSwigluBf E{(bf16*)(C.ws + WS_U)}; REP(9, (pg8::gemm_phase<pg8::EpiSwigluBf, pg8::StaticOrder, true, true>(w.lds, g, S, E, w.tid)));
#endif
            }
            else { const int* gm = (const int*)(C.ws + WS_META); const int rows = __builtin_amdgcn_readfirstlane(gm[16]);
                pg8::MoeOrder S; S.S.init(rows, 5632, w.G, w.bid); S.nN = 22;
#pragma unroll
                for (int e = 0; e < NEXP; ++e) S.ts[e] = __builtin_amdgcn_readfirstlane(gm[8 + e]) >> 8;
                LAS unsigned short* toks = (LAS unsigned short*)(w.lds + TOK_LDS); const unsigned short* TOK = (const unsigned short*)(C.ws + WS_TOK);
                for (int i = 0; i < TOK_UNITS; ++i) { pg8::Unit u; if (!S.next(i, u)) break; if (w.tid < 256) toks[i * 256 + w.tid] = TOK[u.pm * 256 + w.tid]; }
                __syncthreads();
#if I8_MOE
                pg8::Gemm g{H, (const bf16*)(C.ws + WS_W13M), rows, 5632, 512};
                pg8::EpiSwiglu E{(bf16*)(C.ws + WS_U), (const float*)(C.ws + WS_SAP), (const float*)C.ws + CM_W13M + (l >> 1) * NEXP * 5632}; REP(9, (pg8::gemm_phase<pg8::EpiSwiglu, pg8::MoeOrder, true, true, true>(w.lds, g, S, E, w.tid, toks)));
#else
                pg8::Gemm g{H, (const bf16*)(C.ws + WS_W13M), rows, 5632, 1024};
                pg8::EpiSwigluBf E{(bf16*)(C.ws + WS_U)}; REP(9, (pg8::gemm_phase<pg8::EpiSwigluBf, pg8::MoeOrder, true, true, true>(w.lds, g, S, E, w.tid, toks)));
#endif
            }
        }
        PH_END;
        if (PH_RUN) { MKC();
            if (!moe) { pg8::Gemm g{(const bf16*)(C.ws + WS_U), (const bf16*)(C.ws + WS_W2D) + (size_t)(l >> 1) * 1024 * DFF, MTOK, 1024, DFF}; pg8::StaticOrder S; S.init(MTOK, 1024, w.G, w.bid);
                pg8::EpiResid E{nullptr, (bf16*)(C.ws + WS_XB), MOD + (size_t)l * 2 * 6144 + 5120}; pg8::gemm_phase<pg8::EpiResid, pg8::StaticOrder, true, true>(w.lds, g, S, E, w.tid); }
            else { const int* gm = (const int*)(C.ws + WS_META); const int rows = __builtin_amdgcn_readfirstlane(gm[16]);
                pg8::MoeOrder S; S.S.init(rows, 1024, w.G, w.bid); S.nN = 4;
#pragma unroll
                for (int e = 0; e < NEXP; ++e) S.ts[e] = __builtin_amdgcn_readfirstlane(gm[8 + e]) >> 8;
                pg8::Gemm g{(const bf16*)(C.ws + WS_U), (const bf16*)(C.ws + WS_W2M), rows, 1024, DFF};
                pg8::EpiMoeOut E{(bf16*)(C.ws + WS_AS), (const float*)(C.ws + WS_WPOS)}; REP(10, (pg8::gemm_phase<pg8::EpiMoeOut, pg8::MoeOrder, true, true>(w.lds, g, S, E, w.tid))); }
        }
        PH_END;
    }
    if (PH_RUN) { MKC(); phase_final_combine(C, w, DEPTH - 1); }
#undef PH_RUN
#undef PH_END
#undef H
#undef PROJ
#undef MOD
}

extern "C" void kernel_launch(void* const* d_in, const int* in_sizes, int n_in, void* d_out, int out_size, void* d_ws, size_t ws_size, hipStream_t stream) {
    static int grid = 0;
    if (grid == 0) {
        if (n_in != 31 || out_size != MTOK * DM || ws_size < WS_END) { fprintf(stderr, "kernel_launch: unexpected problem (n_in %d, out %d, ws %zu)\n", n_in, out_size, ws_size); grid = -1; return; }
        int dev = 0, cus = 0, per_cu = 0;
        if (hipGetDevice(&dev) != hipSuccess || hipDeviceGetAttribute(&cus, hipDeviceAttributeMultiprocessorCount, dev) != hipSuccess) { grid = -1; return; }
        if (hipFuncSetAttribute((const void*)fwd_kernel, hipFuncAttributeMaxDynamicSharedMemorySize, LDS_BYTES) != hipSuccess) { grid = -1; return; }
        if (hipOccupancyMaxActiveBlocksPerMultiprocessor(&per_cu, (const void*)fwd_kernel, NTHR, LDS_BYTES) != hipSuccess || per_cu < 1) fprintf(stderr, "kernel_launch: occupancy query reports %d\n", per_cu);
        (void)hipGetLastError();
        grid = cus;
    }
    if (grid < 0) return;
    if (hipMemsetAsync((char*)d_ws + WS_CTL, 0, CTL_ZERO_BYTES, stream) != hipSuccess) return;
    Args a{};
    for (int i = 0; i < 31; ++i) a.in[i] = (const float*)d_in[i];
    a.out = (float*)d_out; a.ws = (unsigned char*)d_ws;
#if MK_PER_PHASE
    for (int p = 0; p < NPHASE; ++p) { a.ph_lo = p; a.ph_hi = p + 1; hipLaunchKernelGGL(fwd_kernel, dim3(grid), dim3(NTHR), LDS_BYTES, stream, a); }
#else
    a.ph_lo = 0; a.ph_hi = NPHASE; hipLaunchKernelGGL(fwd_kernel, dim3(grid), dim3(NTHR), LDS_BYTES, stream, a);
#endif
}
```

```cpp
#include <hip/hip_runtime.h>
#include <cstdio>
#include <cstdint>
#include <cmath>

#ifndef MK_PER_PHASE
#define MK_PER_PHASE 0
#endif

namespace pg8 {
#define PG8_LAS __attribute__((address_space(3)))
typedef unsigned short bf16_t;
typedef short bf16x8 __attribute__((ext_vector_type(8)));
typedef float f32x4 __attribute__((ext_vector_type(4)));
typedef unsigned u32x4 __attribute__((ext_vector_type(4)));
typedef int i32x4 __attribute__((ext_vector_type(4)));
template <class T> __device__ __forceinline__ T vzero4() { T z; z[0] = 0; z[1] = 0; z[2] = 0; z[3] = 0; return z; }
constexpr int BM = 256, BK = 64, HALF = 128, HTB = HALF * BK * 2  , STAGE_BYTES = 8 * HTB, NXCD = 8, WGM = 4, SCL_OFF = 147456  ;

__host__ __device__ __forceinline__ int lds_byte(int r, int c) { const int st = (r >> 4) * 2 + (c >> 5), rr = r & 15, cc = c & 31, ob = rr * 64 + cc * 2; return st * 1024 + (ob ^ (((ob >> 9) & 1) << 5)); }
__host__ __device__ __forceinline__ void stage_rc(int b, int& R, int& C) { const int st = b / 1024, sb = b % 1024, swz = sb ^ (((sb >> 9) & 1) << 5); R = (st >> 1) * 16 + swz / 64; C = (st & 1) * 32 + (swz % 64) / 2; }
__host__ __device__ __forceinline__ int perm32(int rho) { const int n = rho >> 4, i = rho & 15; return 8 * (i >> 2) + 4 * n + (i & 3); }

struct Unit { int pm, pn; };
struct Gemm { const bf16_t* A; const bf16_t* Bt; int M, N, K; };

struct StaticOrder {
    int nM, nN, nwg, G, c;
    __host__ __device__ void init(int M, int N, int G_, int c_) { nM = M / BM; nN = N / BM; nwg = nM * nN; G = G_; c = c_; }
    __host__ __device__ bool next(int i, Unit& u) const {
        const long L = (long)i * G + c; if (L >= nwg) return false;
        int wgid = (int)L; { const int q = nwg / NXCD, r = nwg % NXCD, xcd = wgid % NXCD, off = wgid / NXCD; wgid = (xcd < r ? xcd * (q + 1) : r * (q + 1) + (xcd - r) * q) + off; }
        const int nig = WGM * nN, gid = wgid / nig, fm = gid * WGM, gsz = (nM - fm) < WGM ? (nM - fm) : WGM;
        u.pm = fm + ((wgid % nig) % gsz); u.pn = (wgid % nig) / gsz; return true;
    }
    __device__ __forceinline__ void a_ready(const Unit&) const {}
    __device__ __forceinline__ void done(const Unit&) const {}
};

__device__ __forceinline__ unsigned cvt_pk_bf16(float lo, float hi) { unsigned r; asm volatile("v_cvt_pk_bf16_f32 %0, %1, %2" : "=v"(r) : "v"(lo), "v"(hi)); return r; }
typedef float f32x2 __attribute__((ext_vector_type(2)));
template <class Epi, class Sched, bool ALIGN_EPI = false, bool SP2 = false, bool GATHER = false>
__device__ __forceinline__ void gemm_phase(PG8_LAS unsigned char* lds, const Gemm g, const Sched& S, const Epi& E, int tid_in, const PG8_LAS unsigned short* toks = nullptr) {
    static_assert(!GATHER || SP2, "the gather variant is written for the SP2 loop");
    int tid_l = tid_in; asm volatile("" : "+v"(tid_l));
    const int tid = tid_l, wid = __builtin_amdgcn_readfirstlane(tid >> 6), lane = tid & 63, wr = wid >> 2, wc = wid & 3, fr = lane & 15, fq = lane >> 4;
    const int K = g.K, nt = K / BK;
    unsigned voffA[2], voffB[2], gC2[2]; int gR[2];
#pragma unroll
    for (int i = 0; i < 2; ++i) { int R, C; stage_rc(tid * 16 + i * 8192, R, C); const int Rb = Epi::PERM ? ((R & ~31) + perm32(R & 31)) : R;
        voffA[i] = (unsigned)(R * K + C) * 2u; voffB[i] = (unsigned)(Rb * K + C) * 2u; gR[i] = R; gC2[i] = (unsigned)C * 2u; }
    const size_t kstep = (size_t)(BK * 2);
    const size_t hstep = (size_t)HALF * K * 2;
    const size_t tstep = 2 * hstep;
    const unsigned ldsw = (unsigned)wid * 1024u;
    const int aoff = lds_byte(wr * 64 + fr, fq * 8), boff = lds_byte(wc * 32 + fr, fq * 8);
#define PG8_SA(b, h) (((b) * 2 + (h)) * HTB)
#define PG8_SB(b, h) ((4 + (b) * 2 + (h)) * HTB)
#define PG8_STAGE(bufoff, gbase, voff) do { _Pragma("unroll") for (int _i = 0; _i < 2; ++_i) \
        __builtin_amdgcn_global_load_lds((const unsigned*)((const char*)(gbase) + (voff)[_i]), (PG8_LAS unsigned*)(lds + (bufoff) + ldsw + _i * 8192), 16, 0, 0); } while (0)
#define PG8_STAGE_A(bufoff, gbase, h, nx) do { if constexpr (GATHER) { unsigned s_[2] = { (nx) ? offN[h][0] : offC[h][0], (nx) ? offN[h][1] : offC[h][1] }; PG8_STAGE(bufoff, gbase, s_); } \
        else { PG8_STAGE(bufoff, (gbase) + (h) * hstep, voffA); } } while (0)
#define PG8_GOFF(dst, u) do { int tl_ = fr + 16 * fq; asm volatile("" : "+v"(tl_)); int R_, C_; stage_rc((wid * 64 + tl_) * 16, R_, C_);        \
        _Pragma("unroll") for (int h_ = 0; h_ < 2; ++h_) _Pragma("unroll") for (int i_ = 0; i_ < 2; ++i_) \
        dst[h_][i_] = (unsigned)toks[(u) * 256 + h_ * 128 + R_ + 64 * i_] * (unsigned)(K * 2) + (unsigned)C_ * 2u; } while (0)
#define PG8_LDA(dst, b, h) do { _Pragma("unroll") for (int m = 0; m < 4; ++m) _Pragma("unroll") for (int k = 0; k < 2; ++k) dst[m][k] = *(const PG8_LAS bf16x8*)(lds + PG8_SA(b, h) + aoff + m * 2048 + k * 1024); } while (0)
#define PG8_LDB(dst, b, h) do { _Pragma("unroll") for (int n = 0; n < 2; ++n) _Pragma("unroll") for (int k = 0; k < 2; ++k) dst[n][k] = *(const PG8_LAS bf16x8*)(lds + PG8_SB(b, h) + boff + n * 2048 + k * 1024); } while (0)
#define PG8_MMA(ai, bj, At, Bt) do { __builtin_amdgcn_s_setprio(1); _Pragma("unroll") for (int m = 0; m < 4; ++m) _Pragma("unroll") for (int n = 0; n < 2; ++n) _Pragma("unroll") for (int k = 0; k < 2; ++k) \
        { if constexpr (Epi::I8) acc[ai][bj][m][n] = __builtin_amdgcn_mfma_i32_16x16x64_i8((i32x4)Bt[n][k], (i32x4)At[m][k], acc[ai][bj][m][n], 0, 0, 0); \
          else acc[ai][bj][m][n] = __builtin_amdgcn_mfma_f32_16x16x32_bf16(Bt[n][k], At[m][k], acc[ai][bj][m][n], 0, 0, 0); } __builtin_amdgcn_s_setprio(0); } while (0)
#define PG8_SCL(u_, par) do { if constexpr (Epi::I8) { int tl_ = fr + 16 * fq; asm volatile("" : "+v"(tl_)); \
        const float* gp_ = wid < 4 ? E.sa + (size_t)(u_).pm * BM + wid * 64 + tl_ : E.cm + (size_t)(u_).pn * BM + (wid - 4) * 64 + tl_; \
        __builtin_amdgcn_global_load_lds((const unsigned*)gp_, (PG8_LAS unsigned*)(lds + SCL_OFF + (par) * 2048 + wid * 256), 4, 0, 0); } } while (0)
#define PG8_WAIT_V(n) asm volatile("s_waitcnt vmcnt(" #n ")" ::: "memory")
#define PG8_WAIT_L(n) asm volatile("s_waitcnt lgkmcnt(" #n ")" ::: "memory")
#define PG8_BAR __builtin_amdgcn_s_barrier()
#define PG8_SCHED __builtin_amdgcn_sched_barrier(0)
    Unit cur, nxt; int ui = 0;
    if (!S.next(0, cur)) return;
    typedef typename Epi::acc_t acc_t;
    acc_t acc[2][2][4][2];
#pragma unroll
    for (int a = 0; a < 2; ++a)
#pragma unroll
        for (int b = 0; b < 2; ++b)
#pragma unroll
            for (int m = 0; m < 4; ++m)
#pragma unroll
                for (int n = 0; n < 2; ++n) acc[a][b][m][n] = vzero4<acc_t>();
    bf16x8 At[4][2], B0[2][2], B1[2][2];
    const char* cA = (const char*)g.A + (GATHER ? (size_t)0 : (size_t)cur.pm * tstep); const char* cB = (const char*)g.Bt + (size_t)cur.pn * tstep;
    unsigned offC[2][2], offN[2][2];
    if constexpr (GATHER) { PG8_GOFF(offC, 0); PG8_GOFF(offN, 0); } else { offC[0][0] = offC[0][1] = offC[1][0] = offC[1][1] = 0u; offN[0][0] = offN[0][1] = offN[1][0] = offN[1][1] = 0u; }
    S.a_ready(cur);
    PG8_SCL(cur, 0);
    if constexpr (SP2) {
        PG8_STAGE(PG8_SB(0, 0), cB, voffB); PG8_STAGE(PG8_SB(0, 1), cB + hstep, voffB); PG8_STAGE_A(PG8_SA(0, 0), cA, 0, false); PG8_STAGE_A(PG8_SA(0, 1), cA, 1, false);
        if (wr == 1) PG8_BAR;
        PG8_WAIT_V(2); PG8_BAR;
        PG8_STAGE(PG8_SB(1, 0), cB + kstep, voffB); PG8_STAGE_A(PG8_SA(1, 0), cA + kstep, 0, false); PG8_STAGE(PG8_SB(1, 1), cB + hstep + kstep, voffB);
        PG8_WAIT_V(6); PG8_BAR;
    } else {
        PG8_STAGE(PG8_SB(0, 0), cB, voffB); PG8_STAGE(PG8_SA(0, 0), cA, voffA); PG8_STAGE(PG8_SB(0, 1), cB + hstep, voffB); PG8_STAGE(PG8_SA(0, 1), cA + hstep, voffA);
        if (wr == 1) PG8_BAR;
        PG8_WAIT_V(4); PG8_BAR;
        PG8_STAGE(PG8_SB(1, 0), cB + kstep, voffB); PG8_STAGE(PG8_SA(1, 0), cA + kstep, voffA); PG8_STAGE(PG8_SB(1, 1), cB + hstep + kstep, voffB);
        PG8_WAIT_V(6); PG8_BAR;
    }
    for (;;) {
        const bool has_next = S.next(ui + 1, nxt);
        if constexpr (GATHER) { if (has_next) PG8_GOFF(offN, ui + 1); else { offN[0][0] = offC[0][0]; offN[0][1] = offC[0][1]; offN[1][0] = offC[1][0]; offN[1][1] = offC[1][1]; } }
        const char* nA = (has_next && !GATHER) ? (const char*)g.A + (size_t)nxt.pm * tstep : cA; const char* nB = has_next ? (const char*)g.Bt + (size_t)nxt.pn * tstep : cB;
        for (int t = 0; t < nt; t += 2) {
            const bool last = (t == nt - 2);
            const char* a1 = cA + (size_t)(t + 1) * kstep;
            const char* a2 = last ? nA : cA + (size_t)(t + 2) * kstep; const char* b2 = last ? nB : cB + (size_t)(t + 2) * kstep;
            const char* a3 = a2 + kstep; const char* b3 = b2 + kstep;
            if (last && has_next) { S.a_ready(nxt); PG8_SCL(nxt, (ui + 1) & 1); }
            if constexpr (SP2) {
            PG8_LDB(B0, 0, 0); PG8_LDB(B1, 0, 1); PG8_SCHED; PG8_LDA(At, 0, 0); PG8_STAGE_A(PG8_SA(1, 1), a1, 1, false);
            PG8_WAIT_V(8); PG8_WAIT_L(0); PG8_BAR; PG8_MMA(0, 0, At, B0); PG8_MMA(0, 1, At, B1); PG8_BAR; PG8_SCHED;
            PG8_LDA(At, 0, 1); PG8_STAGE(PG8_SB(0, 0), b2, voffB); PG8_STAGE(PG8_SB(0, 1), b2 + hstep, voffB); PG8_STAGE_A(PG8_SA(0, 0), a2, 0, last);
            PG8_WAIT_V(8); PG8_WAIT_L(0); PG8_BAR; PG8_MMA(1, 0, At, B0); PG8_MMA(1, 1, At, B1); PG8_BAR; PG8_SCHED;
            PG8_LDB(B0, 1, 0); PG8_LDB(B1, 1, 1); PG8_SCHED; PG8_LDA(At, 1, 0); PG8_STAGE_A(PG8_SA(0, 1), a2, 1, last);
            PG8_WAIT_V(8); PG8_WAIT_L(0); PG8_BAR; PG8_MMA(0, 0, At, B0); PG8_MMA(0, 1, At, B1); PG8_BAR; PG8_SCHED;
            PG8_LDA(At, 1, 1); PG8_STAGE(PG8_SB(1, 0), b3, voffB); PG8_STAGE(PG8_SB(1, 1), b3 + hstep, voffB); PG8_STAGE_A(PG8_SA(1, 0), a3, 0, last);
            PG8_WAIT_V(8); PG8_WAIT_L(0); PG8_BAR; PG8_MMA(1, 0, At, B0); PG8_MMA(1, 1, At, B1); PG8_BAR; PG8_SCHED;
            } else {
            PG8_LDB(B0, 0, 0); PG8_SCHED; PG8_LDA(At, 0, 0); PG8_STAGE(PG8_SA(1, 1), a1 + hstep, voffA);
            PG8_WAIT_L(8); PG8_BAR; PG8_WAIT_L(0); PG8_MMA(0, 0, At, B0); PG8_BAR; PG8_SCHED;
            PG8_LDB(B1, 0, 1); PG8_STAGE(PG8_SB(0, 0), b2, voffB);
            PG8_BAR; PG8_WAIT_L(0); PG8_MMA(0, 1, At, B1); PG8_BAR;
            PG8_LDA(At, 0, 1); PG8_STAGE(PG8_SA(0, 0), a2, voffA);
            PG8_BAR; PG8_WAIT_L(0); PG8_MMA(1, 0, At, B0); PG8_BAR; PG8_SCHED;
            PG8_STAGE(PG8_SB(0, 1), b2 + hstep, voffB);
            PG8_WAIT_V(6); PG8_BAR; PG8_MMA(1, 1, At, B1); PG8_BAR;
            PG8_LDB(B0, 1, 0); PG8_SCHED; PG8_LDA(At, 1, 0); PG8_STAGE(PG8_SA(0, 1), a2 + hstep, voffA);
            PG8_WAIT_L(8); PG8_BAR; PG8_WAIT_L(0); PG8_MMA(0, 0, At, B0); PG8_BAR; PG8_SCHED;
            PG8_LDB(B1, 1, 1); PG8_STAGE(PG8_SB(1, 0), b3, voffB);
            PG8_BAR; PG8_WAIT_L(0); PG8_MMA(0, 1, At, B1); PG8_BAR;
            PG8_LDA(At, 1, 1); PG8_STAGE(PG8_SA(1, 0), a3, voffA);
            PG8_BAR; PG8_WAIT_L(0); PG8_MMA(1, 0, At, B0); PG8_BAR; PG8_SCHED;
            PG8_STAGE(PG8_SB(1, 1), b3 + hstep, voffB);
            PG8_WAIT_V(6); PG8_BAR; PG8_MMA(1, 1, At, B1); PG8_BAR;
            }
        }
        if constexpr (ALIGN_EPI) { if (wr == 0) PG8_BAR; }
        if constexpr (!Epi::AFTER_DRAIN) { if constexpr (Epi::I8) E(acc, cur, wr, wc, fr, fq, (const PG8_LAS float*)(lds + SCL_OFF + (ui & 1) * 2048)); else E(acc, cur, wr, wc, fr, fq); S.done(cur); }
        if (!has_next) break;
        if (!E.keep_acc(cur)) {
#pragma unroll
        for (int a = 0; a < 2; ++a)
#pragma unroll
            for (int b = 0; b < 2; ++b)
#pragma unroll
                for (int m = 0; m < 4; ++m)
#pragma unroll
                    for (int n = 0; n < 2; ++n) acc[a][b][m][n] = vzero4<acc_t>();
        }
        cur = nxt; cA = nA; cB = nB; ++ui;
        if constexpr (GATHER) { offC[0][0] = offN[0][0]; offC[0][1] = offN[0][1]; offC[1][0] = offN[1][0]; offC[1][1] = offN[1][1]; }
        if constexpr (ALIGN_EPI) { if (wr == 1) PG8_BAR; }
    }
    PG8_WAIT_V(0);
    if constexpr (!ALIGN_EPI) { if (wr == 0) PG8_BAR; }
    PG8_BAR;
    if constexpr (Epi::AFTER_DRAIN) { E.fused(acc, cur, wr, wc, fr, fq, lds, wid, lane); S.done(cur); }
#undef PG8_SA
#undef PG8_SB
#undef PG8_STAGE
#undef PG8_STAGE_A
#undef PG8_GOFF
#undef PG8_LDA
#undef PG8_LDB
#undef PG8_MMA
#undef PG8_SCL
#undef PG8_WAIT_V
#undef PG8_WAIT_L
#undef PG8_BAR
#undef PG8_SCHED
}
}

#define GAS __attribute__((address_space(1)))
#define LAS __attribute__((address_space(3)))
typedef unsigned short bf16;
typedef unsigned v4u __attribute__((ext_vector_type(4)));
typedef unsigned v2u __attribute__((ext_vector_type(2)));
typedef float f32x4 __attribute__((ext_vector_type(4)));
typedef float f32x2 __attribute__((ext_vector_type(2)));
typedef float f32x16 __attribute__((ext_vector_type(16)));
typedef short bf16x8 __attribute__((ext_vector_type(8)));
typedef short s16x4 __attribute__((ext_vector_type(4)));
typedef GAS unsigned gu32;
#define RLX_AGENT __ATOMIC_RELAXED, __HIP_MEMORY_SCOPE_AGENT
#define LDS_WAIT() asm volatile("s_waitcnt lgkmcnt(0)" ::: "memory")
#define VM_WAIT() asm volatile("s_waitcnt vmcnt(0)" ::: "memory")
__device__ __forceinline__ unsigned f2bf(float f) { unsigned u = __builtin_bit_cast(unsigned, f); return (u + 0x7fffu + ((u >> 16) & 1u)) >> 16; }
typedef __bf16 bf16x2_t __attribute__((ext_vector_type(2)));
__device__ __forceinline__ unsigned pk2(float lo, float hi) { f32x2 v = {lo, hi}; bf16x2_t b = __builtin_convertvector(v, bf16x2_t); return __builtin_bit_cast(unsigned, b); }
__device__ __forceinline__ unsigned fbits(float f) { return __builtin_bit_cast(unsigned, f); }
__device__ __forceinline__ float bf2f(unsigned b) { return __builtin_bit_cast(float, b << 16); }
__device__ __forceinline__ float bflo(unsigned w) { return __builtin_bit_cast(float, w << 16); }
__device__ __forceinline__ float bfhi(unsigned w) { return __builtin_bit_cast(float, w & 0xffff0000u); }
__device__ __forceinline__ float fexp2(float x) { return __builtin_amdgcn_exp2f(x); }
__device__ __forceinline__ float fexp(float x) { return __builtin_amdgcn_exp2f(x * 1.4426950408889634f); }
__device__ __forceinline__ float flog(float x) { return __builtin_amdgcn_logf(x) * 0.6931471805599453f; }
__device__ __forceinline__ float frcp(float x) { return __builtin_amdgcn_rcpf(x); }
__device__ __forceinline__ float fsigmoid(float x) { return frcp(1.f + fexp(-x)); }
__device__ __forceinline__ float fsilu(float x) { return x * fsigmoid(x); }
__device__ __forceinline__ int lane_now() { int x; asm volatile("v_mbcnt_lo_u32_b32 %0, -1, 0\n\tv_mbcnt_hi_u32_b32 %0, -1, %0" : "=v"(x)); return x; }
template <int CTRL, int ROWMASK = 0xF> __device__ __forceinline__ float dppf(float old, float v) { return __builtin_bit_cast(float, __builtin_amdgcn_update_dpp(__builtin_bit_cast(int, old), __builtin_bit_cast(int, v), CTRL, ROWMASK, 0xF, false)); }
__device__ __forceinline__ float wave_sum(float v) {
    v += dppf<0xB1>(0.f, v); v += dppf<0x4E>(0.f, v); v += dppf<0x141>(0.f, v); v += dppf<0x140>(0.f, v);
    v += dppf<0x142, 0xA>(0.f, v); v += dppf<0x143, 0xC>(0.f, v);
    return __builtin_bit_cast(float, __builtin_amdgcn_readlane(__builtin_bit_cast(int, v), 63));
}
__device__ __forceinline__ float wave_max_nonneg(float v) {
    v = __builtin_fmaxf(v, dppf<0xB1>(0.f, v)); v = __builtin_fmaxf(v, dppf<0x4E>(0.f, v)); v = __builtin_fmaxf(v, dppf<0x141>(0.f, v)); v = __builtin_fmaxf(v, dppf<0x140>(0.f, v));
    v = __builtin_fmaxf(v, dppf<0x142, 0xA>(0.f, v)); v = __builtin_fmaxf(v, dppf<0x143, 0xC>(0.f, v));
    return __builtin_bit_cast(float, __builtin_amdgcn_readlane(__builtin_bit_cast(int, v), 63));
}
#define XB_TMO      128
#define XB_XCNT(j)  (256  + 64 * (j))
#define XB_XSUB(j)  (1280 + 64 * (j))
#define XB_XGEN(j)  (2304 + 64 * (j))
#define XB_TOP      3328
#define XB_TOPGEN   3392
#define XCD_BAR_WORDS 3456
#define XB_SPIN_CAP (1u << 18)

__device__ __forceinline__ unsigned xb_ld(unsigned* p)              { return __hip_atomic_load(p, __ATOMIC_RELAXED, __HIP_MEMORY_SCOPE_AGENT); }
__device__ __forceinline__ unsigned xb_add(unsigned* p, unsigned v) { return __hip_atomic_fetch_add(p, v, __ATOMIC_RELAXED, __HIP_MEMORY_SCOPE_AGENT); }
__device__ __forceinline__ unsigned xb_xcc_id() { return (unsigned)__builtin_amdgcn_s_getreg((3 << 11) | 20) & 0xFu; }
#define XB_SPIN(cond, bar) do { unsigned _sp = 0; while (cond) { __builtin_amdgcn_s_sleep(1); \
    if ((++_sp & 255u) == 0u) { if (xb_ld(&(bar)[XB_TMO])) break; if (_sp > XB_SPIN_CAP) { atomicAdd(&(bar)[XB_TMO], 1u); break; } } } } while (0)

struct XcdBarrier {
    unsigned* bar; unsigned x;
    volatile LAS unsigned* st;
};

__device__ __forceinline__ XcdBarrier xcd_barrier_post(unsigned* bar, volatile LAS unsigned* st, bool t0) {
    XcdBarrier b; b.bar = bar; b.x = xb_xcc_id(); b.st = st;
    if (t0) (void)xb_add(&bar[XB_XCNT(b.x)], 1u);
    return b;
}
__device__ __forceinline__ void xcd_barrier_complete(unsigned* bar, unsigned x, unsigned& nloc, unsigned& nx) {
    const unsigned G = gridDim.x * gridDim.y * gridDim.z;
    unsigned sum, cnt, mine, sp = 0u;
    for (;;) {
        sum = 0u; cnt = 0u; mine = 0u;
#pragma unroll
        for (unsigned j = 0; j < 16; ++j) { const unsigned c = xb_ld(&bar[XB_XCNT(j)]); sum += c; cnt += (c > 0u) ? 1u : 0u; mine = (j == x) ? c : mine; }
        if (sum == G) break;
        __builtin_amdgcn_s_sleep(1);
        if ((++sp & 255u) == 0u) { if (xb_ld(&bar[XB_TMO])) break; if (sp > XB_SPIN_CAP) { atomicAdd(&bar[XB_TMO], 1u); break; } }
    }
    nloc = mine > 0u ? mine : 1u; nx = cnt > 0u ? cnt : 1u;
}

__device__ __forceinline__ void xcd_barrier(const XcdBarrier& b, bool t0) {
    asm volatile("s_waitcnt vmcnt(0)" ::: "memory");
    __syncthreads();
    if (t0) {
        unsigned* bar = b.bar;
        __builtin_amdgcn_s_waitcnt(0);
        unsigned nloc = b.st[0], nx = b.st[1];
        if (nloc == 0u) { xcd_barrier_complete(bar, b.x, nloc, nx); b.st[0] = nloc; b.st[1] = nx; }
        const unsigned old = xb_add(&bar[XB_XSUB(b.x)], 1u);
        const unsigned gen = old / nloc;
        if (old + 1u == (gen + 1u) * nloc) {
            __builtin_amdgcn_fence(__ATOMIC_RELEASE, "agent");
            asm volatile("s_waitcnt vmcnt(0)" ::: "memory");
            const unsigned og = xb_add(&bar[XB_TOP], 1u);
            const unsigned tg = og / nx;
            if (og + 1u == (tg + 1u) * nx) xb_add(&bar[XB_TOPGEN], 1u);
            else XB_SPIN(xb_ld(&bar[XB_TOPGEN]) == tg, bar);
            __builtin_amdgcn_fence(__ATOMIC_ACQUIRE, "agent");
            xb_add(&bar[XB_XGEN(b.x)], 1u);
            asm volatile("s_waitcnt vmcnt(0)" ::: "memory");
        } else {
            XB_SPIN(xb_ld(&bar[XB_XGEN(b.x)]) == gen, bar);
            __builtin_amdgcn_fence(__ATOMIC_ACQUIRE, "agent");
            asm volatile("s_waitcnt vmcnt(0)" ::: "memory");
        }
    }
    __syncthreads();
}

#ifndef I8_MOE
#define I8_MOE 1
#endif
#ifndef I8_DENSE
#define I8_DENSE 1
#endif
constexpr int NWAVES = 8, NTHR = 512;
constexpr int NB = 2, SEQ = 16384, DM = 1024, MTOK = NB * SEQ, DEPTH = 4;
constexpr int D_IN = 8712, PROJ_N = 5632  , WIN_ROWS = 8704  , NGATE0 = 5632, NGATE = 3072, DFF = 2816, NEXP = 8;
constexpr int C_AQ = 0, C_AK = 512, C_AV = 1024, C_BQ = 1536, C_BF = 2048, C_BI = 2560, C_BG = 3072, C_CQ = 3584, C_CK = 4096, C_CV = 4608, C_CO = 5120;
constexpr int MOE_ROWS = 2 * MTOK + NEXP * 256;
constexpr float NORM_EPS = 1e-6f;
constexpr size_t MiB = 1u << 20;
constexpr size_t WS_CTL = 0, CTL_ZERO_BYTES = 1 * MiB;
constexpr size_t WS_MOD = 1 * MiB;
constexpr size_t WS_META = 1 * MiB + 512 * 1024;
constexpr size_t WS_TOK = WS_META + 64 * 1024;
constexpr size_t WS_CIF = 2 * MiB;
constexpr size_t WS_RE = 3 * MiB;
constexpr size_t WS_RW = WS_RE + 128 * 1024;
constexpr size_t WS_POS = WS_RW + 256 * 1024;
constexpr size_t WS_WPOS = WS_POS + 256 * 1024;
constexpr size_t WS_STS = 4 * MiB;
constexpr size_t WS_STA = 20 * MiB;
constexpr size_t WS_STN = 20 * MiB + 256 * 1024;
constexpr size_t WS_SA = 20 * MiB + 512 * 1024;
constexpr size_t WS_SAP = 20 * MiB + 640 * 1024;
constexpr size_t WS_WIN = 22 * MiB;
constexpr size_t WS_WBR = 90 * MiB;
constexpr size_t WS_WOUT = 102 * MiB;
constexpr size_t WS_W13D = 110 * MiB;
constexpr size_t WS_W2D = 132 * MiB;
constexpr size_t WS_H = 144 * MiB;
constexpr size_t WS_PROJ = 208 * MiB;
constexpr size_t WS_GATE8 = 560 * MiB;
constexpr size_t WS_Y = 752 * MiB;
constexpr size_t WS_ATTO = 848 * MiB;
constexpr size_t WS_XB = 912 * MiB;
constexpr size_t WS_END = 976 * MiB;
constexpr size_t WS_U = WS_PROJ;
constexpr size_t WS_W13M = WS_PROJ + 364 * MiB;
constexpr size_t WS_W2M = WS_PROJ + 452 * MiB;
constexpr size_t WS_AS = WS_PROJ + 496 * MiB;
static_assert(WS_AS + (size_t)MOE_ROWS * 1024 * 2 <= WS_END && WS_U + (size_t)MOE_ROWS * DFF * 2 <= WS_W13M && WS_W13M + (size_t)8 * 5632 * 1024 * 2 <= WS_W2M && WS_W2M + (size_t)8 * 1024 * DFF * 2 <= WS_AS, "overlay map");
constexpr int CW_BAR = 4096;
constexpr int CW_QUEUE = 8192;
constexpr int CW_CNT = 16384;
constexpr int CW_CM = 32768;
constexpr int CM_W13D = CW_CM, CM_W13M = CW_CM + 2 * 5632, CM_WIN = CM_W13M + 16 * 5632  , CM_END = CM_WIN + DEPTH * WIN_ROWS;
static_assert((size_t)CM_END * 4 <= CTL_ZERO_BYTES, "CTL map");
constexpr int LDS_BYTES = 147456 + 4096;
constexpr int RING_BYTES = 131072, MISC_OFF = RING_BYTES + 320;
constexpr int TOK_LDS = RING_BYTES + 1024, TOK_UNITS = 23;
static_assert(TOK_LDS + TOK_UNITS * 512 <= 147456, "LDS map");

struct Ctx {
    const float *x, *c, *w_mod, *b_mod, *norm1_w, *norm2_w, *w_in, *conv_w, *conv_b, *qn_w, *kn_w, *lq1, *lk1, *lq2, *lk2, *subln_w, *lb_logits, *gnorm_w,
                *ig_b, *fg_b, *cnorm_w, *w_branch, *w_out, *ffn_w1, *ffn_w3, *ffn_w2, *router_w, *router_b, *moe_w1, *moe_w3, *moe_w2;
    float* out; unsigned char* ws;
};

namespace pg8 {
__device__ __forceinline__ unsigned pkbf(float lo, float hi) { return cvt_pk_bf16(lo, hi); }
struct EpiProj {
    static constexpr bool PERM = true, AFTER_DRAIN = false, I8 = true; typedef i32x4 acc_t; __device__ __forceinline__ bool keep_acc(const Unit&) const { return false; } bf16_t* O; const float* qnw; const float* knw; unsigned char* G8; const float* sa; const float* cm;
    __device__ __forceinline__ void operator()(const i32x4 (&acc)[2][2][4][2], const Unit& u, int wr, int wc, int fr, int fq, const PG8_LAS float* scl) const {
        const int row0 = u.pm * BM + wr * 64 + fr;
        const PG8_LAS float* cp = scl + 256 + wc * 32 + 8 * fq; const PG8_LAS float* sp = scl + wr * 64 + fr;
        f32x4 sb[2][2];
#pragma unroll
        for (int bj = 0; bj < 2; ++bj)
#pragma unroll
            for (int n = 0; n < 2; ++n) sb[bj][n] = *(const PG8_LAS f32x4*)(cp + bj * HALF + 4 * n) * (1.0f / 127.0f);
#define EP_DQ(ai, bj, m, n, s) (__builtin_convertvector(acc[ai][bj][m][n], f32x4) * ((s) * sb[bj][n]))
        if (u.pn < 4) {
            const float* wp = (u.pn < 2 ? qnw : knw) + 8 * fq; const float scl = u.pn < 2 ? 0.125f * 1.4426950408889634f : 1.0f;
            f32x4 wv[2][2];
#pragma unroll
            for (int bj = 0; bj < 2; ++bj)
#pragma unroll
                for (int n = 0; n < 2; ++n) wv[bj][n] = *(const f32x4*)(wp + 32 * bj + 4 * n) * scl;
            const int col0 = u.pn * BM + wc * 64 + 8 * fq;
#pragma unroll
            for (int ai = 0; ai < 2; ++ai)
#pragma unroll
                for (int m = 0; m < 4; ++m) { float ss = 0.f; const float s = sp[ai * HALF + m * 16]; f32x4 vv[2][2];
#pragma unroll
                    for (int bj = 0; bj < 2; ++bj)
#pragma unroll
                        for (int n = 0; n < 2; ++n) { const f32x4 v = EP_DQ(ai, bj, m, n, s); vv[bj][n] = v; ss += (v[0] * v[0] + v[1] * v[1]) + (v[2] * v[2] + v[3] * v[3]); }
                    ss += __shfl_xor(ss, 16); ss += __shfl_xor(ss, 32);
                    const float rstd = __builtin_amdgcn_rsqf(ss * (1.0f / 64.0f) + 1e-6f);
                    bf16_t* rowp = O + (size_t)(row0 + ai * HALF + m * 16) * PROJ_N + col0;
#pragma unroll
                    for (int bj = 0; bj < 2; ++bj) { const f32x4 v0 = vv[bj][0] * rstd * wv[bj][0], v1 = vv[bj][1] * rstd * wv[bj][1];
                        u32x4 w; w.x = pkbf(v0[0], v0[1]); w.y = pkbf(v0[2], v0[3]); w.z = pkbf(v1[0], v1[1]); w.w = pkbf(v1[2], v1[3]);
                        *(u32x4*)(rowp + bj * 32) = w; } }
            return;
        }
        const int col0 = u.pn * BM + wc * 32 + 8 * fq;
        if (u.pn >= 22) {
            const int gc0 = col0 - NGATE0;
#pragma unroll
            for (int bj = 0; bj < 2; ++bj)
#pragma unroll
                for (int n = 0; n < 2; ++n) sb[bj][n] = sb[bj][n] * -1.4426950408889634f;
#pragma unroll
            for (int ai = 0; ai < 2; ++ai)
#pragma unroll
                for (int m = 0; m < 4; ++m) { unsigned char* rowp = G8 + (size_t)(row0 + ai * HALF + m * 16) * NGATE + gc0; const float s = sp[ai * HALF + m * 16];
#pragma unroll
                    for (int bj = 0; bj < 2; ++bj) { const f32x4 v0 = EP_DQ(ai, bj, m, 0, s), v1 = EP_DQ(ai, bj, m, 1, s); unsigned q[8];
#pragma unroll
                        for (int k = 0; k < 4; ++k) { q[k] = (unsigned)(255.0f * __builtin_amdgcn_rcpf(1.f + __builtin_amdgcn_exp2f(v0[k])) + 0.5f);
                                                      q[4 + k] = (unsigned)(255.0f * __builtin_amdgcn_rcpf(1.f + __builtin_amdgcn_exp2f(v1[k])) + 0.5f); }
                        typedef unsigned u32x2v __attribute__((ext_vector_type(2)));
                        *(u32x2v*)(rowp + bj * HALF) = (u32x2v){q[0] | (q[1] << 8) | (q[2] << 16) | (q[3] << 24), q[4] | (q[5] << 8) | (q[6] << 16) | (q[7] << 24)}; } }
            return;
        }
#pragma unroll
        for (int ai = 0; ai < 2; ++ai)
#pragma unroll
            for (int m = 0; m < 4; ++m) { bf16_t* rowp = O + (size_t)(row0 + ai * HALF + m * 16) * PROJ_N + col0; const float s = sp[ai * HALF + m * 16];
#pragma unroll
                for (int bj = 0; bj < 2; ++bj) { const f32x4 v0 = EP_DQ(ai, bj, m, 0, s), v1 = EP_DQ(ai, bj, m, 1, s);
                    u32x4 w; w.x = pkbf(v0[0], v0[1]); w.y = pkbf(v0[2], v0[3]); w.z = pkbf(v1[0], v1[1]); w.w = pkbf(v1[2], v1[3]);
                    *(u32x4*)(rowp + bj * HALF) = w; } }
#undef EP_DQ
    }
};
struct EpiResid {
    static constexpr bool PERM = true, AFTER_DRAIN = false, I8 = false; typedef f32x4 acc_t; __device__ __forceinline__ bool keep_acc(const Unit&) const { return false; } const float* x32; bf16_t* xb; const float* gate;
    __device__ __forceinline__ void operator()(const f32x4 (&acc)[2][2][4][2], const Unit& u, int wr, int wc, int fr, int fq) const {
        const int col0 = u.pn * BM + wc * 32 + 8 * fq; const float* gp = gate + ((u.pm * BM) >> 14) * 6144 + col0;
        f32x4 gv[2][2];
#pragma unroll
        for (int bj = 0; bj < 2; ++bj)
#pragma unroll
            for (int n = 0; n < 2; ++n) gv[bj][n] = *(const f32x4*)(gp + bj * HALF + 4 * n);
        const size_t off0 = (size_t)(u.pm * BM + wr * 64 + fr) * 1024 + col0;
        if (x32 != nullptr) {
#pragma unroll
            for (int ai = 0; ai < 2; ++ai)
#pragma unroll
                for (int mp = 0; mp < 2; ++mp) { f32x4 xi[2][2][2];
#pragma unroll
                    for (int m2 = 0; m2 < 2; ++m2)
#pragma unroll
                        for (int bj = 0; bj < 2; ++bj) { const float* xp = x32 + off0 + (size_t)(ai * HALF + (2 * mp + m2) * 16) * 1024 + bj * HALF; xi[m2][bj][0] = *(const f32x4*)xp; xi[m2][bj][1] = *(const f32x4*)(xp + 4); }
#pragma unroll
                    for (int m2 = 0; m2 < 2; ++m2)
#pragma unroll
                        for (int bj = 0; bj < 2; ++bj) { const int m = 2 * mp + m2; const f32x4 v0 = xi[m2][bj][0] + gv[bj][0] * acc[ai][bj][m][0], v1 = xi[m2][bj][1] + gv[bj][1] * acc[ai][bj][m][1];
                            u32x4 w; w.x = pkbf(v0[0], v0[1]); w.y = pkbf(v0[2], v0[3]); w.z = pkbf(v1[0], v1[1]); w.w = pkbf(v1[2], v1[3]);
                            *(u32x4*)(xb + off0 + (size_t)(ai * HALF + m * 16) * 1024 + bj * HALF) = w; } }
        } else {
#pragma unroll
            for (int ai = 0; ai < 2; ++ai) { u32x4 xr[4][2];
#pragma unroll
                for (int m = 0; m < 4; ++m)
#pragma unroll
                    for (int bj = 0; bj < 2; ++bj) xr[m][bj] = *(const u32x4*)(xb + off0 + (size_t)(ai * HALF + m * 16) * 1024 + bj * HALF);
#pragma unroll
                for (int m = 0; m < 4; ++m)
#pragma unroll
                    for (int bj = 0; bj < 2; ++bj) { const u32x4 r = xr[m][bj]; const f32x4 a0 = acc[ai][bj][m][0], a1 = acc[ai][bj][m][1], g0 = gv[bj][0], g1 = gv[bj][1];
                        u32x4 w; w.x = pkbf(__builtin_bit_cast(float, r.x << 16) + g0[0] * a0[0], __builtin_bit_cast(float, r.x & 0xffff0000u) + g0[1] * a0[1]);
                        w.y = pkbf(__builtin_bit_cast(float, r.y << 16) + g0[2] * a0[2], __builtin_bit_cast(float, r.y & 0xffff0000u) + g0[3] * a0[3]);
                        w.z = pkbf(__builtin_bit_cast(float, r.z << 16) + g1[0] * a1[0], __builtin_bit_cast(float, r.z & 0xffff0000u) + g1[1] * a1[1]);
                        w.w = pkbf(__builtin_bit_cast(float, r.w << 16) + g1[2] * a1[2], __builtin_bit_cast(float, r.w & 0xffff0000u) + g1[3] * a1[3]);
                        *(u32x4*)(xb + off0 + (size_t)(ai * HALF + m * 16) * 1024 + bj * HALF) = w; } }
        }
    }
};
struct EpiSwiglu {
    static constexpr bool PERM = true, AFTER_DRAIN = false, I8 = true; typedef i32x4 acc_t; __device__ __forceinline__ bool keep_acc(const Unit&) const { return false; } bf16_t* U; const float* sa; const float* cm;
    __device__ __forceinline__ void operator()(const i32x4 (&acc)[2][2][4][2], const Unit& u, int wr, int wc, int fr, int fq, const PG8_LAS float* scl) const {
        const int row0 = u.pm * BM + wr * 64 + fr, col0 = (u.pn % 22) * HALF + wc * 32 + 8 * fq;
        const PG8_LAS float* cp = scl + 256 + wc * 32 + 8 * fq; const PG8_LAS float* sp = scl + wr * 64 + fr;
        f32x4 sb[2][2];
#pragma unroll
        for (int n = 0; n < 2; ++n) { sb[0][n] = *(const PG8_LAS f32x4*)(cp + 4 * n) * (-1.4426950408889634f / 127.0f); sb[1][n] = *(const PG8_LAS f32x4*)(cp + HALF + 4 * n) * (-0.6931471805599453f / 127.0f); }
#pragma unroll
        for (int ai = 0; ai < 2; ++ai) { float sr[4];
#pragma unroll
            for (int m = 0; m < 4; ++m) sr[m] = sp[ai * HALF + m * 16];
#pragma unroll
            for (int m = 0; m < 4; ++m) { const float s = sr[m]; f32x4 ov[2];
#pragma unroll
                for (int n = 0; n < 2; ++n) { const f32x4 x = __builtin_convertvector(acc[ai][0][m][n], f32x4) * (s * sb[0][n]), y = __builtin_convertvector(acc[ai][1][m][n], f32x4) * (s * sb[1][n]);
                    const float x0 = x.x, x1 = x.y, x2 = x.z, x3 = x.w;
                    const f32x4 e = {__builtin_amdgcn_exp2f(x0), __builtin_amdgcn_exp2f(x1), __builtin_amdgcn_exp2f(x2), __builtin_amdgcn_exp2f(x3)};
                    const f32x4 den = e + 1.0f; const float d0 = den.x, d1 = den.y, d2 = den.z, d3 = den.w;
                    const f32x4 r = {__builtin_amdgcn_rcpf(d0), __builtin_amdgcn_rcpf(d1), __builtin_amdgcn_rcpf(d2), __builtin_amdgcn_rcpf(d3)};
                    ov[n] = x * y * r; }
                const float o0 = ov[0].x, o1 = ov[0].y, o2 = ov[0].z, o3 = ov[0].w, o4 = ov[1].x, o5 = ov[1].y, o6 = ov[1].z, o7 = ov[1].w;
                u32x4 w; w.x = pkbf(o0, o1); w.y = pkbf(o2, o3); w.z = pkbf(o4, o5); w.w = pkbf(o6, o7);
                *(u32x4*)(U + (size_t)(row0 + ai * HALF + m * 16) * DFF + col0) = w; } }
    }
};
struct EpiSwigluBf {
    static constexpr bool PERM = true, AFTER_DRAIN = false, I8 = false; typedef f32x4 acc_t; __device__ __forceinline__ bool keep_acc(const Unit&) const { return false; } bf16_t* U;
    __device__ __forceinline__ void operator()(const f32x4 (&acc)[2][2][4][2], const Unit& u, int wr, int wc, int fr, int fq) const {
        const int row0 = u.pm * BM + wr * 64 + fr, col0 = (u.pn % 22) * HALF + wc * 32 + 8 * fq;
#pragma unroll
        for (int ai = 0; ai < 2; ++ai)
#pragma unroll
            for (int m = 0; m < 4; ++m) { float o[8];
#pragma unroll
                for (int n = 0; n < 2; ++n)
#pragma unroll
                    for (int k = 0; k < 4; ++k) { const float a = acc[ai][0][m][n][k], g = acc[ai][1][m][n][k]; o[4 * n + k] = a * __builtin_amdgcn_rcpf(1.f + __builtin_amdgcn_exp2f(-1.4426950408889634f * a)) * g; }
                u32x4 w; w.x = pkbf(o[0], o[1]); w.y = pkbf(o[2], o[3]); w.z = pkbf(o[4], o[5]); w.w = pkbf(o[6], o[7]);
                *(u32x4*)(U + (size_t)(row0 + ai * HALF + m * 16) * DFF + col0) = w; }
    }
};
struct EpiMoeOut {
    static constexpr bool PERM = true, AFTER_DRAIN = false, I8 = false; typedef f32x4 acc_t; __device__ __forceinline__ bool keep_acc(const Unit&) const { return false; } bf16_t* O; const float* wpos;
    __device__ __forceinline__ void operator()(const f32x4 (&acc)[2][2][4][2], const Unit& u, int wr, int wc, int fr, int fq) const {
        const int row0 = u.pm * BM + wr * 64 + fr, col0 = (u.pn & 3) * BM + wc * 32 + 8 * fq;
#pragma unroll
        for (int ai = 0; ai < 2; ++ai)
#pragma unroll
            for (int m = 0; m < 4; ++m) { const int r = row0 + ai * HALF + m * 16; const float s = wpos[r];
#pragma unroll
                for (int bj = 0; bj < 2; ++bj) { const f32x4 v0 = acc[ai][bj][m][0] * s, v1 = acc[ai][bj][m][1] * s;
                    u32x4 w; w.x = pkbf(v0[0], v0[1]); w.y = pkbf(v0[2], v0[3]); w.z = pkbf(v1[0], v1[1]); w.w = pkbf(v1[2], v1[3]);
                    *(u32x4*)(O + (size_t)r * 1024 + col0 + bj * HALF) = w; } }
    }
};
struct MoeOrder {
    StaticOrder S; int nN; int ts[NEXP];
    __device__ __forceinline__ bool next(int i, Unit& u) const {
        if (!S.next(i, u)) return false;
        int e = 0;
#pragma unroll
        for (int k = 1; k < NEXP; ++k) e += (u.pm >= ts[k]) ? 1 : 0;
        u.pn += e * nN; return true;
    }
    __device__ __forceinline__ void a_ready(const Unit&) const {}
    __device__ __forceinline__ void done(const Unit&) const {}
};
struct EpiMergeChain {
    static constexpr bool PERM = true, AFTER_DRAIN = false, I8 = false; typedef f32x4 acc_t; const unsigned char* G8; bf16_t* O;
    __device__ __forceinline__ bool keep_acc(const Unit& u) const { return (u.pm >> 7) < 2; }
    __device__ __forceinline__ void operator()(f32x4 (&acc)[2][2][4][2], const Unit& u, int wr, int wc, int fr, int fq) const {
        typedef unsigned u32x2v __attribute__((ext_vector_type(2)));
        const int part = u.pm >> 7, pm = u.pm & 127, pn = u.pn & 3;
        const int row0 = pm * BM + wr * 64 + fr, col0 = pn * BM + wc * 32 + 8 * fq;
        const float gmin = 255.0f * 8.6736174e-19f;
        u32x2v ga[2][2][2], gb[2][2][2];
        const GAS unsigned char* gbase = (const GAS unsigned char*)G8 + (size_t)row0 * NGATE + part * 1024 + col0;
#define MC_LOAD(b_, buf_) do { _Pragma("unroll") for (int m2 = 0; m2 < 2; ++m2) _Pragma("unroll") for (int bj = 0; bj < 2; ++bj) { \
            const GAS unsigned char* gp = gbase + (size_t)((((b_) >> 1) * HALF) + (2 * ((b_) & 1) + m2) * 16) * NGATE + bj * HALF; ga[buf_][m2][bj] = *(const GAS u32x2v*)gp; \
            gb[buf_][m2][bj] = part < 2 ? *(const GAS u32x2v*)(gp + 1024) : (u32x2v){0xffffffffu, 0xffffffffu}; } } while (0)
        MC_LOAD(0, 0);
#pragma unroll
        for (int b4 = 0; b4 < 4; ++b4) { const int ai = b4 >> 1, mp = b4 & 1;
            if (b4 < 3) MC_LOAD(b4 + 1, (b4 + 1) & 1);
#pragma unroll
            for (int m2 = 0; m2 < 2; ++m2) { const int m = 2 * mp + m2; const size_t r = (size_t)(row0 + ai * HALF + m * 16);
#pragma unroll
                for (int bj = 0; bj < 2; ++bj) { const u32x2v a = ga[b4 & 1][m2][bj], b = gb[b4 & 1][m2][bj]; float s[8];
#pragma unroll
                    for (int k = 0; k < 8; ++k) { const float ga_ = __builtin_fmaxf((float)((a[k >> 2] >> (8 * (k & 3))) & 0xffu), gmin), gb_ = __builtin_fmaxf((float)((b[k >> 2] >> (8 * (k & 3))) & 0xffu), gmin);
                        s[k] = ga_ * __builtin_amdgcn_rcpf(gb_); }
                    f32x4 v0 = acc[ai][bj][m][0], v1 = acc[ai][bj][m][1];
                    v0[0] *= s[0]; v0[1] *= s[1]; v0[2] *= s[2]; v0[3] *= s[3]; v1[0] *= s[4]; v1[1] *= s[5]; v1[2] *= s[6]; v1[3] *= s[7];
                    acc[ai][bj][m][0] = v0; acc[ai][bj][m][1] = v1;
                    if (part == 2) { u32x4 w; w.x = pkbf(v0[0], v0[1]); w.y = pkbf(v0[2], v0[3]); w.z = pkbf(v1[0], v1[1]); w.w = pkbf(v1[2], v1[3]);
                        *(u32x4*)(O + r * 1024 + col0 + bj * HALF) = w; } } }
        }
#undef MC_LOAD
    }
};
struct MergeOrder {
    StaticOrder S;
    __device__ __forceinline__ bool next(int i, Unit& u) const {
        const int j = i / 3, part = i - 3 * j;
        if (!S.next(j, u)) return false;
        u.pm += part * 128; u.pn += part * 4; return true;
    }
    __device__ __forceinline__ void a_ready(const Unit&) const {}
    __device__ __forceinline__ void done(const Unit&) const {}
};
}

struct WG { LAS unsigned char* lds; int tid, lane, wave, G, bid; };

struct CvtItem { const float* src; unsigned char* dst; int pitch, K; const float* cm; };
__device__ __forceinline__ void cvt_load(const CvtItem& it, f32x4 (&r)[8], int lane) {
#pragma unroll
    for (int i = 0; i < 8; ++i) r[i] = *(const f32x4*)(it.src + (size_t)(8 * i + (lane >> 3)) * it.pitch + (lane & 7) * 4);
}
__device__ __forceinline__ void cvt_finish(const CvtItem& it, const f32x4 (&r)[8], LAS float* scr, int lane) {
#pragma unroll
    for (int i = 0; i < 8; ++i) *(LAS f32x4*)(scr + (8 * i + (lane >> 3)) * 36 + (((lane & 7) * 4 + 4 * i) & 31)) = r[i];
    LDS_WAIT(); asm volatile("" ::: "memory");
    const int c = lane & 7;
    if (it.cm != nullptr) {
#pragma unroll
        for (int j = 0; j < 4; ++j) { const int n = (lane >> 3) + 8 * j; const LAS float* s = scr + (8 * c) * 36 + ((n + 4 * c) & 31);
            const float inv = 127.0f * frcp(__builtin_fmaxf(it.cm[n], 1e-30f)); unsigned q[8];
#pragma unroll
            for (int i = 0; i < 8; ++i) q[i] = (unsigned)(int)__builtin_rintf(s[i * 36] * inv) & 0xffu;
#if I8_DENSE == 2
            { const float dq = it.cm[n] * (1.0f / 127.0f); float f[8];
#pragma unroll
              for (int i = 0; i < 8; ++i) f[i] = (float)(int)(signed char)q[i] * dq;
              v4u o4; o4.x = pk2(f[0], f[1]); o4.y = pk2(f[2], f[3]); o4.z = pk2(f[4], f[5]); o4.w = pk2(f[6], f[7]);
              *(GAS v4u*)(it.dst + ((size_t)n * it.K + 8 * c) * 2) = o4; }
#else
            v2u o; o.x = q[0] | (q[1] << 8) | (q[2] << 16) | (q[3] << 24); o.y = q[4] | (q[5] << 8) | (q[6] << 16) | (q[7] << 24);
            *(GAS v2u*)(it.dst + (size_t)n * it.K + 8 * c) = o;
#endif
            }
    } else {
#pragma unroll
    for (int j = 0; j < 4; ++j) { const int n = (lane >> 3) + 8 * j; const LAS float* s = scr + (8 * c) * 36 + ((n + 4 * c) & 31);
        v4u o; o.x = pk2(s[0 * 36], s[1 * 36]); o.y = pk2(s[2 * 36], s[3 * 36]); o.z = pk2(s[4 * 36], s[5 * 36]); o.w = pk2(s[6 * 36], s[7 * 36]);
        *(GAS v4u*)(it.dst + ((size_t)n * it.K + 8 * c) * 2) = o; }
    }
    LDS_WAIT(); asm volatile("" ::: "memory");
}
__device__ __forceinline__ int cvt_drow(int mode, int row_off, int n0) { return mode == 0 ? row_off + n0 : mode == 3 ? ((n0 & ~255) + 128 * ((n0 >> 5) & 1) + 32 * ((n0 >> 6) & 3)) : ((n0 >> 7) * 256 + (n0 & 127) + (mode == 2 ? 128 : 0)); }
__device__ __forceinline__ CvtItem cvt_mk(const float* W, int pitch, int col0, int K, int nblk, void* WT, int mode, int row_off, int idx, const float* cm = nullptr) {
    const int kb = idx / nblk, nb = idx - kb * nblk, n0 = nb * 32;
    const int drow = cvt_drow(mode, row_off, n0);
    CvtItem it; it.src = W + (size_t)(kb * 64) * pitch + col0 + n0; it.dst = (unsigned char*)WT + ((size_t)drow * K + kb * 64) * ((cm != nullptr && I8_DENSE != 2) ? 1 : 2); it.pitch = pitch; it.K = K; it.cm = cm != nullptr ? cm + drow : nullptr; return it;
}
constexpr int CVT_WIN = 512 + 2304 + 1536, CVT_L = 768 + 512, CVT_F = 3 * 1408, CVT_PRO = DEPTH * CVT_L + 2 * 1408, CVT_QWIN = DEPTH * CVT_WIN, CVT_Q13D = 2 * 2816, CVT_MOE = NEXP * CVT_F;
__device__ __forceinline__ CvtItem cvt_ffn(const float* w1, const float* w3, const float* w2, void* w13, bf16* w2t, const float* cm, int r) {
    if (r < 1408) return cvt_mk(w1, DFF, 0, 1024, 88, w13, 1, 0, r, cm);
    if (r < 2816) return cvt_mk(w3, DFF, 0, 1024, 88, w13, 2, 0, r - 1408, cm);
    return cvt_mk(w2, 1024, 0, DFF, 32, w2t, 0, 0, r - 2816);
}
__device__ __forceinline__ CvtItem cvt_pro_item(const Ctx& C, int it) {
    if (it < DEPTH * CVT_L) { const int l = it / CVT_L; int r = it - l * CVT_L;
        if (r < 768) { const int i = r >> 8; return cvt_mk(C.w_branch + (size_t)(l * 3 + i) * 512 * 1024, 1024, 0, 512, 32, (bf16*)(C.ws + WS_WBR) + (size_t)(l * 3 + i) * 1024 * 512, 0, 0, r & 255); }
        r -= 768; return cvt_mk(C.w_out + (size_t)l * 1024 * 1024, 1024, 0, 1024, 32, (bf16*)(C.ws + WS_WOUT) + (size_t)l * 1024 * 1024, 0, 0, r);
    }
    it -= DEPTH * CVT_L; const int i = it / 1408;
    return cvt_mk(C.ffn_w2 + (size_t)i * DFF * 1024, 1024, 0, DFF, 32, (bf16*)(C.ws + WS_W2D) + (size_t)i * 1024 * DFF, 0, 0, it - i * 1408);
}
__device__ __forceinline__ CvtItem cvt_qwin_item(const Ctx& C, int it) {
    const int l = it / CVT_WIN; int r = it - l * CVT_WIN;
    const float* wi = C.w_in + (size_t)l * 1024 * D_IN; unsigned char* win = C.ws + WS_WIN + (size_t)l * WIN_ROWS * 1024; const float* cm = (const float*)C.ws + CM_WIN + l * WIN_ROWS;
    if (r < 512) return cvt_mk(wi, D_IN, 0, 1024, 32, win, 3, 0, r, cm);
    r -= 512; if (r < 2304) return cvt_mk(wi, D_IN, 1024, 1024, 144, win, 0, 1024, r, cm);
    r -= 2304; return cvt_mk(wi, D_IN, 5640, 1024, 96, win, 0, NGATE0, r, cm);
}
__device__ __forceinline__ CvtItem cvt_q13d_item(const Ctx& C, int it) {
    const int i = it / 2816, r = it - i * 2816, which = r >= 1408 ? 1 : 0;
    const float* const p1 = C.ffn_w1; const float* const p3 = C.ffn_w3; const float* W = (which ? p3 : p1) + (size_t)i * 1024 * DFF;
    return cvt_mk(W, DFF, 0, 1024, 88, C.ws + WS_W13D + (size_t)i * 5632 * 1024 * (I8_DENSE == 1 ? 1 : 2), 1 + which, 0, r - which * 1408, I8_DENSE ? (const float*)C.ws + CM_W13D + i * 5632 : nullptr);
}
__device__ __forceinline__ CvtItem cvt_moe_item(const Ctx& C, int mi, int it) {
    const int e = it / CVT_F; const size_t ge = (size_t)(mi * NEXP + e);
    return cvt_ffn(C.moe_w1 + ge * 1024 * DFF, C.moe_w3 + ge * 1024 * DFF, C.moe_w2 + ge * DFF * 1024, C.ws + WS_W13M + (size_t)e * 5632 * 1024 * (I8_MOE ? 1 : 2), (bf16*)(C.ws + WS_W2M) + (size_t)e * 1024 * DFF,
                   I8_MOE ? (const float*)C.ws + CM_W13M + (mi * NEXP + e) * 5632 : nullptr, it - e * CVT_F);
}
constexpr int AMX_PER = 88 * 8, AMX_FFN = 36 * AMX_PER, AMX_WIN_PER = 272 * 8, AMX_ITEMS = AMX_FFN + DEPTH * AMX_WIN_PER;
__device__ __forceinline__ void amx_run(const Ctx& C, const WG& w, int sel) {
    const int gw = w.bid * NWAVES + w.wave, NGW = w.G * NWAVES, lane = w.lane;
    const int nitems = sel == 0 ? 4 * AMX_PER + DEPTH * AMX_WIN_PER : 16 * AMX_PER, base = sel == 0 ? 0 : (4 + 16 * (sel - 1)) * AMX_PER;
    const float* const pd1 = C.ffn_w1; const float* const pd3 = C.ffn_w3; const float* const pm1 = C.moe_w1; const float* const pm3 = C.moe_w3; const float* const pwi = C.w_in;
    for (int j = gw; j < nitems; j += NGW) {
        const int it = (sel == 0 && j >= 4 * AMX_PER) ? AMX_FFN + (j - 4 * AMX_PER) : base + j;
        const float* src; unsigned* cm; int pitch;
        if (it < AMX_FFN) {
            const int mat = it / AMX_PER, r = it - mat * AMX_PER, kp = r / 88, nb = r - kp * 88, set = mat >> 1, which = mat & 1, n0 = nb * 32;
            const float* W = set < 2 ? (which ? pd3 : pd1) + (size_t)set * 1024 * DFF : (which ? pm3 : pm1) + (size_t)(set - 2) * 1024 * DFF;
            src = W + (size_t)(kp * 128) * DFF + n0; pitch = DFF; cm = (unsigned*)C.ws + CM_W13D + set * 5632 + cvt_drow(which ? 2 : 1, 0, n0);
        } else {
            const int r0 = it - AMX_FFN, l = r0 / AMX_WIN_PER, r = r0 - l * AMX_WIN_PER, kp = r / 272, b = r - kp * 272;
            const int col = b < 176 ? 32 * b : 5640 + 32 * (b - 176), drow = b < 32 ? cvt_drow(3, 0, 32 * b) : b < 176 ? 32 * b : NGATE0 + 32 * (b - 176);
            src = pwi + (size_t)l * 1024 * D_IN + (size_t)(kp * 128) * D_IN + col; pitch = D_IN; cm = (unsigned*)C.ws + CM_WIN + l * WIN_ROWS + drow;
        }
        src += (size_t)(lane >> 3) * pitch + (lane & 7) * 4;
        f32x4 rr[16];
#pragma unroll
        for (int i = 0; i < 16; ++i) rr[i] = *(const f32x4*)(src + (size_t)(8 * i) * pitch);
        float m0 = 0.f, m1 = 0.f, m2 = 0.f, m3 = 0.f;
#pragma unroll
        for (int i = 0; i < 16; ++i) { const f32x4 t = rr[i]; m0 = __builtin_fmaxf(m0, __builtin_fabsf(t.x)); m1 = __builtin_fmaxf(m1, __builtin_fabsf(t.y)); m2 = __builtin_fmaxf(m2, __builtin_fabsf(t.z)); m3 = __builtin_fmaxf(m3, __builtin_fabsf(t.w)); }
#define AMX_RED_(v) v = __builtin_fmaxf(v, __shfl_xor(v, 8)); v = __builtin_fmaxf(v, __shfl_xor(v, 16)); v = __builtin_fmaxf(v, __shfl_xor(v, 32));
        AMX_RED_(m0) AMX_RED_(m1) AMX_RED_(m2) AMX_RED_(m3)
#undef AMX_RED_
        if (lane < 8) { cm += lane * 4;
            __hip_atomic_fetch_max(cm + 0, __builtin_bit_cast(unsigned, m0), RLX_AGENT); __hip_atomic_fetch_max(cm + 1, __builtin_bit_cast(unsigned, m1), RLX_AGENT);
            __hip_atomic_fetch_max(cm + 2, __builtin_bit_cast(unsigned, m2), RLX_AGENT); __hip_atomic_fetch_max(cm + 3, __builtin_bit_cast(unsigned, m3), RLX_AGENT); }
    }
}
#define CVT_RUN(NITEMS, MKITEM) do { LAS float* scr_ = (LAS float*)(w.lds + w.wave * 9216); const int gw_ = w.bid * NWAVES + w.wave, NGW_ = w.G * NWAVES; \
        int it_ = gw_; if (it_ < (NITEMS)) { CvtItem cur_ = MKITEM(it_); f32x4 ra_[8], rb_[8]; cvt_load(cur_, ra_, w.lane); \
            for (;;) { const int n1_ = it_ + NGW_; CvtItem nx_ = cur_; if (n1_ < (NITEMS)) { nx_ = MKITEM(n1_); cvt_load(nx_, rb_, w.lane); } cvt_finish(cur_, ra_, scr_, w.lane); if (n1_ >= (NITEMS)) break; \
                       const int n2_ = n1_ + NGW_; cur_ = nx_; if (n2_ < (NITEMS)) { cur_ = MKITEM(n2_); cvt_load(cur_, ra_, w.lane); } cvt_finish(nx_, rb_, scr_, w.lane); if (n2_ >= (NITEMS)) break; it_ = n2_; } } } while (0)

__device__ __forceinline__ void phase_prologue(const Ctx& C, const WG& w) {
    float* MOD = (float*)(C.ws + WS_MOD);
    {
        LAS float* cond = (LAS float*)(w.lds + 73728); LAS float* red = cond + 2048;
        for (int i = w.tid; i < 2048; i += NTHR) { const float c = C.c[i]; cond[i] = c * fsigmoid(c); }
        __syncthreads();
        for (int u = w.bid; u < 192; u += w.G) {
            const int l = u / 48, nb = u % 48, c4 = w.tid & 31, kq = w.tid >> 5;
            const float* W = C.w_mod + (size_t)l * 1024 * 6144 + nb * 128 + c4 * 4;
            f32x4 a0 = {0.f, 0.f, 0.f, 0.f}, a1 = {0.f, 0.f, 0.f, 0.f};
#pragma unroll 16
            for (int k = kq * 64; k < kq * 64 + 64; ++k) { const f32x4 wv = *(const f32x4*)(W + (size_t)k * 6144); a0 += cond[k] * wv; a1 += cond[1024 + k] * wv; }
            *(LAS f32x4*)(red + (kq * 2 + 0) * 128 + c4 * 4) = a0; *(LAS f32x4*)(red + (kq * 2 + 1) * 128 + c4 * 4) = a1;
            __syncthreads();
            if (w.tid < 256) { const int b = w.tid >> 7, cc = w.tid & 127; float s = 0.f;
#pragma unroll
                for (int q = 0; q < 16; ++q) s += red[(q * 2 + b) * 128 + cc];
                MOD[(l * 2 + b) * 6144 + nb * 128 + cc] = s + C.b_mod[l * 6144 + nb * 128 + cc]; }
            __syncthreads();
        }
    }
#define MKI_(x) cvt_pro_item(C, (x))
    CVT_RUN(CVT_PRO, MKI_);
#undef MKI_
    amx_run(C, w, 0);
}
__device__ __forceinline__ void phase_cvt_qwin(const Ctx& C, const WG& w) {
#define MKI_(x) cvt_qwin_item(C, (x))
    CVT_RUN(CVT_QWIN, MKI_);
#undef MKI_
}
__device__ __forceinline__ void phase_cvt_q13d(const Ctx& C, const WG& w) {
#define MKI_(x) cvt_q13d_item(C, (x))
    CVT_RUN(CVT_Q13D, MKI_);
#undef MKI_
}
__device__ __forceinline__ void phase_cvt_moe(const Ctx& C, const WG& w, int mi) {
#define MKI_(x) cvt_moe_item(C, mi, (x))
    CVT_RUN(CVT_MOE, MKI_);
#undef MKI_
}

template <int MODE>
__device__ __forceinline__ void phase_norm(const Ctx& C, const WG& w, int l, bool combine) {
    const float* MOD = (const float*)(C.ws + WS_MOD);
    const bool x32 = (MODE == 0 && l == 0);
    const float* xin = C.x; bf16* XB = (bf16*)(C.ws + WS_XB);
    bf16* H = (bf16*)(C.ws + WS_H);
    LAS float* wa = (LAS float*)w.lds;
    if (MODE == 0) { const float* src = C.w_in + (size_t)l * 1024 * D_IN + 5632;
        for (int i = w.tid; i < 8192; i += NTHR) { const int k = i >> 3, c = i & 7, slot = (((k >> 8) * 4 + (k & 3)) * 64 + ((k >> 2) & 63)); wa[((c >> 2) * 1024 + slot) * 4 + (c & 3)] = src[(size_t)k * D_IN + c]; } }
    if (MODE == 2) { const float* src = C.router_w + (size_t)(l >> 1) * 8192;
        for (int i = w.tid; i < 8192; i += NTHR) { const int k = i >> 3, c = i & 7, slot = (((k >> 8) * 4 + (k & 3)) * 64 + ((k >> 2) & 63)); wa[((c >> 2) * 1024 + slot) * 4 + (c & 3)] = src[i]; } }
    __syncthreads();
    const float* nw = (MODE == 0 ? C.norm1_w : C.norm2_w) + l * 1024;
    const int sh_off = MODE == 0 ? 0 : 3072, sc_off = sh_off + 1024;
    const int gw = w.bid * NWAVES + w.wave, NGW = w.G * NWAVES, lane = w.lane;
    f32x4 av[4], sv[4]; int curb = -1;
    const bf16* OP = (const bf16*)(C.ws + WS_AS); const unsigned* POS = (const unsigned*)(C.ws + WS_POS);
    f32x4 vn[4]; v2u rn[4], rn2[4];
#pragma unroll
    for (int j = 0; j < 4; ++j) { if (x32) vn[j] = *(const f32x4*)(xin + (size_t)gw * 1024 + 4 * lane + 256 * j); else { rn[j] = *(const v2u*)(XB + (size_t)gw * 1024 + 4 * lane + 256 * j); rn2[j] = *(const v2u*)(XB + (size_t)(gw + NGW) * 1024 + 4 * lane + 256 * j); } }
    for (int m0 = gw; m0 < MTOK; m0 += 2 * NGW) {
#pragma unroll
      for (int u = 0; u < 2; ++u) { const int m = m0 + u * NGW;
        const int b = m >> 14;
        if (b != curb) { curb = b; const float* mp = MOD + (l * 2 + b) * 6144;
#pragma unroll
            for (int j = 0; j < 4; ++j) { const f32x4 nv = *(const f32x4*)(nw + 4 * lane + 256 * j), sc = *(const f32x4*)(mp + sc_off + 4 * lane + 256 * j); av[j] = nv * (sc + 1.0f); sv[j] = *(const f32x4*)(mp + sh_off + 4 * lane + 256 * j); } }
        f32x4 v[4];
#pragma unroll
        for (int j = 0; j < 4; ++j) { const v2u r = u == 0 ? rn[j] : rn2[j]; const f32x4 dec = {bflo(r.x), bfhi(r.x), bflo(r.y), bfhi(r.y)}; v[j] = x32 ? vn[j] : dec; }
        if (x32) { if (m + NGW < MTOK) {
#pragma unroll
            for (int j = 0; j < 4; ++j) vn[j] = *(const f32x4*)(xin + (size_t)(m + NGW) * 1024 + 4 * lane + 256 * j); } }
        else if (m + 2 * NGW < MTOK) {
#pragma unroll
            for (int j = 0; j < 4; ++j) { const v2u r = *(const v2u*)(XB + (size_t)(m + 2 * NGW) * 1024 + 4 * lane + 256 * j); if (u == 0) rn[j] = r; else rn2[j] = r; } }
        if (combine) {
            const unsigned p0 = POS[2 * m], p1 = POS[2 * m + 1]; const float* g2 = MOD + ((l - 1) * 2 + b) * 6144 + 5120;
#pragma unroll
            for (int j = 0; j < 4; ++j) { const v2u a = *(const v2u*)(OP + (size_t)p0 * 1024 + 4 * lane + 256 * j), bq = *(const v2u*)(OP + (size_t)p1 * 1024 + 4 * lane + 256 * j);
                const f32x4 gg = *(const f32x4*)(g2 + 4 * lane + 256 * j);
                f32x4 s; s.x = bflo(a.x) + bflo(bq.x); s.y = bfhi(a.x) + bfhi(bq.x); s.z = bflo(a.y) + bflo(bq.y); s.w = bfhi(a.y) + bfhi(bq.y);
                v[j] = v[j] + gg * s; v2u xo; xo.x = pk2(v[j].x, v[j].y); xo.y = pk2(v[j].z, v[j].w); *(v2u*)(XB + (size_t)m * 1024 + 4 * lane + 256 * j) = xo; }
        }
        float ss = 0.f;
#pragma unroll
        for (int j = 0; j < 4; ++j) ss += (v[j].x * v[j].x + v[j].y * v[j].y) + (v[j].z * v[j].z + v[j].w * v[j].w);
        const float rstd = __builtin_amdgcn_rsqf(wave_sum(ss) * (1.0f / 1024.0f) + NORM_EPS);
        if ((MODE == 1 && !I8_DENSE) || (MODE == 2 && !I8_MOE)) {
#pragma unroll
        for (int j = 0; j < 4; ++j) { v[j] = v[j] * rstd * av[j] + sv[j];
            v2u o; o.x = pk2(v[j].x, v[j].y); o.y = pk2(v[j].z, v[j].w); *(v2u*)(H + (size_t)m * 1024 + 4 * lane + 256 * j) = o; }
        } else {
            float am = 0.f;
#pragma unroll
            for (int j = 0; j < 4; ++j) { v[j] = v[j] * rstd * av[j] + sv[j];
                am = __builtin_fmaxf(am, __builtin_fmaxf(__builtin_fmaxf(__builtin_fabsf(v[j].x), __builtin_fabsf(v[j].y)), __builtin_fmaxf(__builtin_fabsf(v[j].z), __builtin_fabsf(v[j].w)))); }
            am = wave_max_nonneg(am);
            const float inv = 127.0f * frcp(__builtin_fmaxf(am, 1e-30f));
#pragma unroll
            for (int j = 0; j < 4; ++j) { const unsigned q0 = (unsigned)(int)__builtin_rintf(v[j].x * inv) & 0xffu, q1 = (unsigned)(int)__builtin_rintf(v[j].y * inv) & 0xffu, q2 = (unsigned)(int)__builtin_rintf(v[j].z * inv) & 0xffu, q3 = (unsigned)(int)__builtin_rintf(v[j].w * inv);
#if I8_DENSE == 2
                { const float dq = am * (1.0f / 127.0f); v2u o; o.x = pk2((float)(int)(signed char)q0 * dq, (float)(int)(signed char)q1 * dq); o.y = pk2((float)(int)(signed char)q2 * dq, (float)(int)(signed char)(q3 & 0xffu) * dq);
                  *(v2u*)(H + (size_t)m * 1024 + 4 * lane + 256 * j) = o; }
#else
                *(unsigned*)((unsigned char*)H + (size_t)m * 1024 + 4 * lane + 256 * j) = q0 | (q1 << 8) | (q2 << 16) | (q3 << 24);
#endif
                }
            if (lane == 0) ((float*)(C.ws + WS_SA))[m] = am * (1.0f / 127.0f);
        }
        if (MODE != 1) {
            f32x4 aq0 = {0.f, 0.f, 0.f, 0.f}, aq1 = {0.f, 0.f, 0.f, 0.f};
#pragma unroll
            for (int j = 0; j < 4; ++j)
#pragma unroll
                for (int i = 0; i < 4; ++i) { const LAS f32x4* wp = (const LAS f32x4*)(wa + ((j * 4 + i) * 64 + lane) * 4); const f32x4 w0 = wp[0], w1 = wp[1024]; const float hv = v[j][i];
                    aq0 = aq0 + hv * w0; aq1 = aq1 + hv * w1; }
            float a[8] = {aq0.x, aq0.y, aq0.z, aq0.w, aq1.x, aq1.y, aq1.z, aq1.w};
#pragma unroll
            for (int c = 0; c < 8; ++c) a[c] = wave_sum(a[c]);
            if (MODE == 0) { if (lane == 0) { float* cp = (float*)(C.ws + WS_CIF) + (size_t)m * 8; *(f32x4*)cp = (f32x4){a[0], a[1], a[2], a[3]}; *(f32x4*)(cp + 4) = (f32x4){a[4], a[5], a[6], a[7]}; } }
            if (MODE == 2 && lane == 0) {
                const float* rb = C.router_b + (l >> 1) * 8;
                float b1 = -INFINITY, b2 = -INFINITY; int e1 = 0, e2 = 0;
#pragma unroll
                for (int c = 0; c < 8; ++c) { const float lg = a[c] + rb[c]; if (lg > b1) { b2 = b1; e2 = e1; b1 = lg; e1 = c; } else if (lg > b2) { b2 = lg; e2 = c; } }
                const float w1 = frcp(1.0f + fexp(b2 - b1));
                ((unsigned*)(C.ws + WS_RE))[m] = (unsigned)e1 | ((unsigned)e2 << 8);
                *(f32x2*)((float*)(C.ws + WS_RW) + 2 * (size_t)m) = (f32x2){w1, 1.0f - w1};
                unsigned* cnt = (unsigned*)C.ws + CW_CNT + (l >> 1) * 2048 + (m >> 7) * 8;
                __hip_atomic_fetch_add(cnt + e1, 1u, RLX_AGENT); __hip_atomic_fetch_add(cnt + e2, 1u, RLX_AGENT);
            }
        }
      }
    }
}

__device__ __forceinline__ void phase_gather(const Ctx& C, const WG& w, int mi) {
    LAS int* cl = (LAS int*)w.lds;
    LAS int* meta = cl + 2048;
    LAS int* ppos = meta + 64;
    LAS unsigned* rel = (LAS unsigned*)(ppos + 256);
    const unsigned* cnt = (const unsigned*)C.ws + CW_CNT + mi * 2048;
    for (int i = w.tid; i < 2048; i += NTHR) cl[i] = (int)__hip_atomic_load((unsigned*)cnt + i, RLX_AGENT);
    __syncthreads();
    if (w.tid < 8) { int run = 0; for (int c = 0; c < 256; ++c) { const int t = cl[c * 8 + w.tid]; cl[c * 8 + w.tid] = run; run += t; } meta[w.tid] = run; }
    __syncthreads();
    if (w.tid == 0) { int off = 0; for (int e = 0; e < 8; ++e) { meta[8 + e] = off; off += (meta[e] + 255) & ~255; } meta[16] = off; }
    __syncthreads();
    int* gmeta = (int*)(C.ws + WS_META);
    if (w.bid == 0 && w.tid < 17) gmeta[w.tid] = meta[w.tid];
    const unsigned* RE = (const unsigned*)(C.ws + WS_RE); const float* RW = (const float*)(C.ws + WS_RW);
    unsigned* POS = (unsigned*)(C.ws + WS_POS); float* WPOS = (float*)(C.ws + WS_WPOS);
    unsigned short* TOK = (unsigned short*)(C.ws + WS_TOK); const float* SA = (const float*)(C.ws + WS_SA); float* SAP = (float*)(C.ws + WS_SAP);
    for (int ch = w.bid; ch < 256; ch += w.G) {
        __syncthreads();
        if (w.tid < 128) rel[w.tid] = RE[ch * 128 + w.tid];
        __syncthreads();
        if (w.tid < 8) { const int e = w.tid; int p = meta[8 + e] + cl[ch * 8 + e];
            for (int t = 0; t < 128; ++t) { const unsigned re = rel[t]; if ((int)(re & 0xff) == e) ppos[2 * t] = p++; if ((int)(re >> 8) == e) ppos[2 * t + 1] = p++; } }
        __syncthreads();
        if (w.tid < 256) { const int t = w.tid >> 1, k = w.tid & 1; const int p = ppos[w.tid]; POS[2 * (ch * 128 + t) + k] = (unsigned)p; WPOS[p] = RW[2 * (ch * 128 + t) + k]; TOK[p] = (unsigned short)(ch * 128 + t); SAP[p] = SA[ch * 128 + t]; }
    }
    for (int e = 0; e < 8; ++e) { const int r0 = meta[8 + e] + meta[e], r1 = meta[9 + e];
        for (int r = r0 + w.bid * NTHR + w.tid; r < r1; r += w.G * NTHR) { TOK[r] = 0; WPOS[r] = 0.f; SAP[r] = 0.f; } }
}
__device__ __forceinline__ void phase_final_combine(const Ctx& C, const WG& w, int l) {
    const float* MOD = (const float*)(C.ws + WS_MOD); const bf16* OP = (const bf16*)(C.ws + WS_AS); const unsigned* POS = (const unsigned*)(C.ws + WS_POS);
    const int gw = w.bid * NWAVES + w.wave, NGW = w.G * NWAVES, lane = w.lane;
    for (int m = gw; m < MTOK; m += NGW) {
        const int b = m >> 14; const unsigned p0 = POS[2 * m], p1 = POS[2 * m + 1]; const float* g2 = MOD + (l * 2 + b) * 6144 + 5120;
#pragma unroll
        for (int j = 0; j < 4; ++j) { const v2u a = *(const v2u*)(OP + (size_t)p0 * 1024 + 4 * lane + 256 * j), bq = *(const v2u*)(OP + (size_t)p1 * 1024 + 4 * lane + 256 * j);
            const f32x4 gg = *(const f32x4*)(g2 + 4 * lane + 256 * j); const v2u xr = *(const v2u*)((const bf16*)(C.ws + WS_XB) + (size_t)m * 1024 + 4 * lane + 256 * j); const f32x4 v = {bflo(xr.x), bfhi(xr.x), bflo(xr.y), bfhi(xr.y)};
            f32x4 s; s.x = bflo(a.x) + bflo(bq.x); s.y = bfhi(a.x) + bfhi(bq.x); s.z = bflo(a.y) + bflo(bq.y); s.w = bfhi(a.y) + bfhi(bq.y);
            *(f32x4*)(C.out + (size_t)m * 1024 + 4 * lane + 256 * j) = v + gg * s; }
    }
}

constexpr int AT_K = 0, AT_V = 16384, AT_SCR = 49152, ATT_THR = 8;
__device__ __forceinline__ int crow(int r, int hi) { return (r & 3) + 8 * (r >> 2) + 4 * hi; }
__device__ __forceinline__ s16x4 vtr(const LAS unsigned char* p) { return __builtin_bit_cast(s16x4, __builtin_amdgcn_ds_read_tr16_b64_v4i16((LAS s16x4*)p)); }
__device__ __forceinline__ void attn_unit(const Ctx& C, const WG& w, int l, int b, int h, int mp, int qb, int jlo, float mref, float smax2) {
    int lane_u = w.lane; asm volatile("" : "+v"(lane_u));
    const int lane = lane_u, wid = w.wave, r32 = lane & 31, hh = lane >> 5;
    const bf16* P = (const bf16*)(C.ws + WS_PROJ);
    const size_t rowb = (size_t)b * SEQ; const int q0 = qb * 256;
    bf16x8 qf[4];
    { const bf16* qp = P + (rowb + q0 + wid * 32 + r32) * PROJ_N + C_AQ + mp * 256 + h * 64 + 8 * hh;
#pragma unroll
      for (int s = 0; s < 4; ++s) qf[s] = *(const bf16x8*)(qp + 16 * s); }
    const bf16* kp = P + (rowb + lane) * PROJ_N + C_AK + mp * 256 + h * 64 + 8 * wid;
    const bf16* vp0 = P + (rowb + 16 * (wid & 3) + (lane >> 2)) * PROJ_N + C_AV + h * 128 + 32 * (wid >> 2) + 8 * (lane & 3);
    const bf16* vp1 = vp0 + 64;
    const int kdst = AT_K + wid * 1024, vdst0 = AT_V + (wid >> 2) * 4096 + (wid & 3) * 1024, vdst1 = vdst0 + 8192;
#define AT_DMA(j, buf) do { const size_t ro = (size_t)(j) * 64 * PROJ_N; \
        __builtin_amdgcn_global_load_lds((const unsigned*)(kp + ro), (LAS unsigned*)(w.lds + (buf) * 8192 + kdst), 16, 0, 0); \
        __builtin_amdgcn_global_load_lds((const unsigned*)(vp0 + ro), (LAS unsigned*)(w.lds + (buf) * 16384 + vdst0), 16, 0, 0); \
        __builtin_amdgcn_global_load_lds((const unsigned*)(vp1 + ro), (LAS unsigned*)(w.lds + (buf) * 16384 + vdst1), 16, 0, 0); } while (0)
#define AT_WAITBAR() asm volatile("s_waitcnt vmcnt(0) lgkmcnt(0)\n\ts_barrier" ::: "memory")
    const float slope2 = exp2f(-2.0f * (float)(h + 1)) * 1.4426950408889634f;
    const int jhi = qb * 4 + 3, cw = qb * 4 + (wid >> 1);
    const int tq = q0 + wid * 32 + r32;
    f32x16 o[4];
#pragma unroll
    for (int d = 0; d < 4; ++d)
#pragma unroll
        for (int r = 0; r < 16; ++r) o[d][r] = 0.f;
    const float mrow = mref;
    f32x16 o5;
#pragma unroll
    for (int r = 0; r < 16; ++r) o5[r] = 0.f;
    const unsigned one2 = (r32 == 0) ? 0x3F803F80u : 0u; const bf16x8 vones = __builtin_bit_cast(bf16x8, (v4u){one2, one2, one2, one2});
    const int vbase = AT_V + (4 * hh + ((lane & 15) >> 2)) * 64 + ((lane >> 4) & 1) * 32 + (lane & 3) * 8;
    const int kbase = AT_K + hh * 1024 + r32 * 16;
    float scb[16];
#pragma unroll
    for (int r = 0; r < 16; ++r) scb[r] = slope2 * (float)((r & 3) + 8 * (r >> 2));
    LAS float* lmin = (LAS float*)(w.lds + AT_SCR + 2048);
    const float tailc = smax2 - mref + 6.0f - log2f(1.0f - exp2f(-64.0f * slope2)) + 32.0f;
    if (lane == 0) lmin[wid] = 0.f;
    AT_DMA(jhi, 0);
    AT_WAITBAR();
    for (int jt = jhi; jt >= jlo; --jt) {
        const int buf = (jhi - jt) & 1;
        if (jt < jhi - 3 && ((jhi - jt) & 3) == 0) {
            float lm = lmin[0];
#pragma unroll
            for (int k = 1; k < 8; ++k) lm = fminf(lm, lmin[k]);
            lm = __builtin_bit_cast(float, __builtin_amdgcn_readfirstlane(__builtin_bit_cast(int, lm)));
            const float dmin = (float)(q0 - 64 * jt - 63);
            if (tailc - slope2 * dmin <= __builtin_amdgcn_logf(lm)) break;
        }
        if (jt > jlo) AT_DMA(jt - 1, buf ^ 1);
        if (jt <= cw) {
            f32x16 p0, p1;
            const LAS unsigned char* kb = w.lds + buf * 8192 + kbase;
            bf16x8 ka[4][2];
#pragma unroll
            for (int s = 0; s < 4; ++s) { ka[s][0] = *(const LAS bf16x8*)(kb + s * 2048); ka[s][1] = *(const LAS bf16x8*)(kb + s * 2048 + 512); }
            if (jt < cw) {
                const float b0 = slope2 * (float)(64 * jt + 4 * hh - tq) - mrow, b1 = b0 + 32.0f * slope2;
#pragma unroll
                for (int r = 0; r < 16; ++r) { p0[r] = scb[r] + b0; p1[r] = scb[r] + b1; }
            } else {
                const float dq = (float)(tq - 64 * jt - 4 * hh);
#pragma unroll
                for (int r = 0; r < 16; ++r) { const float cr = (float)((r & 3) + 8 * (r >> 2)); p0[r] = -slope2 * fabsf(dq - cr) - mrow; p1[r] = -slope2 * fabsf(dq - cr - 32.0f) - mrow; }
            }
            __builtin_amdgcn_sched_barrier(0);
#pragma unroll
            for (int s = 0; s < 4; ++s) { p0 = __builtin_amdgcn_mfma_f32_32x32x16_bf16(ka[s][0], qf[s], p0, 0, 0, 0); p1 = __builtin_amdgcn_mfma_f32_32x32x16_bf16(ka[s][1], qf[s], p1, 0, 0, 0); }
            const LAS unsigned char* vb = w.lds + buf * 16384 + vbase;
            bf16x8 vA[4][2], vB[4][2];
#define AT_VLD(dst, k0) do { _Pragma("unroll") for (int d = 0; d < 4; ++d) _Pragma("unroll") for (int k = 0; k < 2; ++k) { \
                const s16x4 lo = vtr(vb + d * 4096 + ((k0) + k) * 1024), hi = vtr(vb + d * 4096 + ((k0) + k) * 1024 + 512); dst[d][k] = (bf16x8){lo[0], lo[1], lo[2], lo[3], hi[0], hi[1], hi[2], hi[3]}; } } while (0)
#define AT_PK(px, ks) __builtin_bit_cast(bf16x8, (v4u){pk2(px[8 * ((ks) & 1) + 0], px[8 * ((ks) & 1) + 1]), pk2(px[8 * ((ks) & 1) + 2], px[8 * ((ks) & 1) + 3]), pk2(px[8 * ((ks) & 1) + 4], px[8 * ((ks) & 1) + 5]), pk2(px[8 * ((ks) & 1) + 6], px[8 * ((ks) & 1) + 7])})
            AT_VLD(vA, 0);
#pragma unroll
            for (int r = 0; r < 16; ++r) p0[r] = fexp2(p0[r]);
            bf16x8 pa[4];
            pa[0] = AT_PK(p0, 0); pa[1] = AT_PK(p0, 1);
            AT_VLD(vB, 2);
#pragma unroll
            for (int k = 0; k < 2; ++k) {
#pragma unroll
                for (int d = 0; d < 4; ++d) o[d] = __builtin_amdgcn_mfma_f32_32x32x16_bf16(pa[k], vA[d][k], o[d], 0, 0, 0);
                o5 = __builtin_amdgcn_mfma_f32_32x32x16_bf16(pa[k], vones, o5, 0, 0, 0); }
#pragma unroll
            for (int r = 0; r < 16; ++r) p1[r] = fexp2(p1[r]);
            pa[2] = AT_PK(p1, 0); pa[3] = AT_PK(p1, 1);
#pragma unroll
            for (int k = 0; k < 2; ++k) {
#pragma unroll
                for (int d = 0; d < 4; ++d) o[d] = __builtin_amdgcn_mfma_f32_32x32x16_bf16(pa[2 + k], vB[d][k], o[d], 0, 0, 0);
                o5 = __builtin_amdgcn_mfma_f32_32x32x16_bf16(pa[2 + k], vones, o5, 0, 0, 0); }
#undef AT_VLD
#undef AT_PK
            if (jt <= jhi - 3 && ((jhi - jt) & 3) == 3) {
                float m = fminf(fminf(fminf(o5[0], o5[1]), fminf(o5[2], o5[3])), fminf(fminf(o5[4], o5[5]), fminf(o5[6], o5[7])));
                m = fminf(m, fminf(fminf(fminf(o5[8], o5[9]), fminf(o5[10], o5[11])), fminf(fminf(o5[12], o5[13]), fminf(o5[14], o5[15]))));
                m = fminf(__shfl(m, 0), __shfl(m, 32));
                if (lane == 0) lmin[wid] = m;
            }
        }
        AT_WAITBAR();
    }
    asm volatile("s_waitcnt vmcnt(0)" ::: "memory");
#undef AT_DMA
#undef AT_WAITBAR
    bf16* O = (bf16*)(C.ws + WS_ATTO) + (size_t)mp * MTOK * 512;
#pragma unroll
    for (int r = 0; r < 16; ++r) { const int qr = crow(r, hh); const float il = frcp(__shfl(o5[r], 32 * hh));
        bf16* op = O + (rowb + q0 + wid * 32 + qr) * 512 + h * 128 + r32;
#pragma unroll
        for (int d = 0; d < 4; ++d) op[d * 32] = (bf16)f2bf(o[d][r] * il); }
    __syncthreads();
}
__device__ __forceinline__ void phase_attention(const Ctx& C, const WG& w, int l, int qsel = 0) {
    float wq = fabsf(C.qn_w[l * 64 + w.lane]), wk = fabsf(C.kn_w[l * 64 + w.lane]);
#pragma unroll
    for (int o = 1; o < 64; o <<= 1) { wq = fmaxf(wq, __shfl_xor(wq, o)); wk = fmaxf(wk, __shfl_xor(wk, o)); }
    const float smax = 8.0f * wq * wk * 1.02f;
    int Wh[4];
#pragma unroll
    for (int h = 0; h < 4; ++h) { const float s = exp2f(-2.0f * (float)(h + 1)); Wh[h] = (int)ceilf((2.0f * smax + 22.180710f - logf(1.0f - expf(-s))) / s) + 1; }
    unsigned* ctr = (unsigned*)C.ws + CW_QUEUE + 64 * l + 16 * qsel;
    if (w.wave >= 4) __builtin_amdgcn_s_setprio(1);
    LAS unsigned* slot = (LAS unsigned*)(w.lds + AT_SCR + 1024);
    for (;;) {
        if (w.tid == 0) *slot = __hip_atomic_fetch_add(ctr, 1u, RLX_AGENT);
        __syncthreads();
        const int k = __builtin_amdgcn_readfirstlane((int)*slot);
        __syncthreads();
        if (k >= 1024) break;
        const int h = 3 - (k >> 8), r = k & 255, qb = 63 - (r >> 2), b = (r >> 1) & 1, mp = r & 1;
        const int Wk = h == 0 ? Wh[0] : h == 1 ? Wh[1] : h == 2 ? Wh[2] : Wh[3];
        int jlo = (qb * 256 - Wk) >> 6; jlo = jlo < 0 ? 0 : jlo;
        attn_unit(C, w, l, b, h, mp, qb, jlo, smax * 1.4426950408889634f - 16.0f, smax * 1.4426950408889634f);
    }
    __builtin_amdgcn_s_setprio(0);
}
__device__ __forceinline__ void phase_attn_combine(const Ctx& C, const WG& w, int l) {
    float s1 = 0.f, s2 = 0.f;
    { const float a = C.lq1[l * 64 + w.lane] * C.lk1[l * 64 + w.lane], c = C.lq2[l * 64 + w.lane] * C.lk2[l * 64 + w.lane]; s1 = wave_sum(a); s2 = wave_sum(c); }
    const float lam_init = 0.8f - 0.6f * expf(-0.3f * (float)l), lam = expf(s1) - expf(s2) + lam_init, post = 1.0f - lam_init;
    const bf16* O0 = (const bf16*)(C.ws + WS_ATTO); const bf16* O1 = O0 + (size_t)MTOK * 512; bf16* Y = (bf16*)(C.ws + WS_Y);
    const int gw = w.bid * NWAVES + w.wave, NGW = w.G * NWAVES, lane = w.lane;
    const float* sw = C.subln_w + l * 128 + (lane & 15) * 8; const f32x4 w0 = *(const f32x4*)sw, w1 = *(const f32x4*)(sw + 4);
    for (int m0 = gw; m0 < MTOK; m0 += 4 * NGW) {
        v4u a[4], c[4];
#pragma unroll
        for (int i = 0; i < 4; ++i) { const int m = m0 + i * NGW; if (m < MTOK) { a[i] = *(const v4u*)(O0 + (size_t)m * 512 + lane * 8); c[i] = *(const v4u*)(O1 + (size_t)m * 512 + lane * 8); } }
#pragma unroll
        for (int i = 0; i < 4; ++i) { const int m = m0 + i * NGW; if (m < MTOK) {
            float v[8]; float ss = 0.f;
#pragma unroll
            for (int k = 0; k < 4; ++k) { v[2 * k] = bflo(a[i][k]) - lam * bflo(c[i][k]); v[2 * k + 1] = bfhi(a[i][k]) - lam * bfhi(c[i][k]); ss += v[2 * k] * v[2 * k] + v[2 * k + 1] * v[2 * k + 1]; }
            ss += __shfl_xor(ss, 1); ss += __shfl_xor(ss, 2); ss += __shfl_xor(ss, 4); ss += __shfl_xor(ss, 8);
            const float sc = post * __builtin_amdgcn_rsqf(ss * (1.0f / 128.0f) + NORM_EPS);
            v4u o; o.x = pk2(v[0] * sc * w0.x, v[1] * sc * w0.y); o.y = pk2(v[2] * sc * w0.z, v[3] * sc * w0.w); o.z = pk2(v[4] * sc * w1.x, v[5] * sc * w1.y); o.w = pk2(v[6] * sc * w1.z, v[7] * sc * w1.w);
            *(v4u*)(Y + (size_t)m * 512 + lane * 8) = o; } }
    }
}

__device__ __forceinline__ unsigned offa(unsigned row, unsigned ch) { return 2048u * (row >> 3) + 512u * (ch >> 2) + 64u * (row & 7) + 16u * ((ch & 3) ^ ((row >> 2) & 3)); }
__device__ __forceinline__ unsigned off2(unsigned row, unsigned ch) { return 1024u * (row >> 3) + 512u * (ch >> 2) + 64u * (row & 7) + 16u * ((ch & 3) ^ ((row >> 2) & 3)); }
constexpr int S2_T0 = 0, S2_T1 = 18432, S2_T2 = 36864, S2_QT = 53248, S2_KU = 69632, S2_ATT = 86016, S2_OST = 94208, S2_AM = 126976, S2_AE = 127488, S2_KS = 128000, S2_NV = 128512, S2_CIF = 129024, S2_NS = 129536, S2_EQ = 130048, S2_EK = 130304, S2_SC = 130560;
template <int MX, int PASS>
__device__ __forceinline__ void scan_unit(const Ctx& C, const WG& w, int l, int b, int h, int seg) {
    int tid_u = w.tid; asm volatile("" : "+v"(tid_u));
    const int tid = tid_u, lane = tid_u & 63, wid = w.wave, dl = lane & 15, g4 = lane >> 4, d = wid * 16 + dl, q4 = (lane & 15) >> 2, p4 = lane & 3;
    const bf16* P = (const bf16*)(C.ws + WS_PROJ);
    const int unit = ((MX * 2 + b) * 4 + h) * 16 + seg;
    const size_t row0 = (size_t)b * SEQ + (size_t)seg * 1024;
    const int c0 = (MX == 0 ? C_BQ : C_CQ) + h * 128, c1 = (MX == 0 ? C_BF : C_CK) + h * 128, c2 = (MX == 0 ? C_BI : C_CV) + h * 128, c3 = (MX == 0 ? C_BG : C_CO) + h * 128;
    constexpr int HALO = MX == 0 ? 0 : 4;
    LAS unsigned char* const L = w.lds;
#define TRB(fn, r0, cc) (fn((unsigned)((r0) + q4), (unsigned)((cc) + (p4 >> 1))) + 8u * (unsigned)(p4 & 1))
    float lbv = 0.f, cwq[4], cwk[4], cbq = 0.f, cbk = 0.f, ibv = 0.f, fbv = 0.f;
    if (MX == 0) { float e[4], s = 0.f, mx = -INFINITY;
#pragma unroll
        for (int k = 0; k < 4; ++k) { e[k] = C.lb_logits[k * 512 + h * 128 + d]; mx = fmaxf(mx, e[k]); }
#pragma unroll
        for (int k = 0; k < 4; ++k) { e[k] = expf(e[k] - mx); s += e[k]; }
        float acc = 0.f;
#pragma unroll
        for (int k = 1; k < 4; ++k) if (k <= l) acc += e[k];
        lbv = acc / s;
    } else {
#pragma unroll
        for (int k = 0; k < 4; ++k) { cwq[k] = C.conv_w[(l * 4 + k) * 1024 + h * 128 + d]; cwk[k] = C.conv_w[(l * 4 + k) * 1024 + 512 + h * 128 + d]; }
        cbq = C.conv_b[l * 1024 + h * 128 + d]; cbk = C.conv_b[l * 1024 + 512 + h * 128 + d]; ibv = C.ig_b[l * 4 + h]; fbv = C.fg_b[l * 4 + h];
    }
    f32x4 S[8];
#pragma unroll
    for (int i = 0; i < 8; ++i) S[i] = (f32x4){0.f, 0.f, 0.f, 0.f};
    float bsum = 0.f;
    const f32x4* STS = (const f32x4*)(C.ws + WS_STS); const float* STA = (const float*)(C.ws + WS_STA); const float* STN = (const float*)(C.ws + WS_STN);
    LAS float* NV = (LAS float*)(L + S2_NV);
    {
        float nacc = 0.f;
        if (PASS == 2) {
            for (int j = 0; j < seg; j += 2) {
                const int uj = unit - seg + j; const bool two = j + 1 < seg; const int uk = two ? uj + 1 : uj;
                f32x4 a0[8], e0[8], a1[8], e1[8];
#pragma unroll
                for (int i = 0; i < 8; ++i) { a0[i] = *(const f32x4*)(STA + uj * 128 + 16 * i + 4 * g4); e0[i] = STS[((size_t)(uj * 8 + wid) * 8 + i) * 64 + lane]; }
#pragma unroll
                for (int i = 0; i < 8; ++i) { a1[i] = *(const f32x4*)(STA + uk * 128 + 16 * i + 4 * g4); e1[i] = STS[((size_t)(uk * 8 + wid) * 8 + i) * 64 + lane]; }
                float na0 = 0.f, ne0 = 0.f, na1 = 0.f, ne1 = 0.f;
                if (MX == 1) { na0 = STA[uj * 128 + d]; ne0 = STN[uj * 128 + d]; na1 = STA[uk * 128 + d]; ne1 = STN[uk * 128 + d]; }
#pragma unroll
                for (int i = 0; i < 8; ++i) { S[i] = a0[i] * S[i] + e0[i]; if (two) S[i] = a1[i] * S[i] + e1[i]; }
                if (MX == 1) { nacc = na0 * nacc + ne0; if (two) nacc = na1 * nacc + ne1; } }
        }
        if (g4 == 0) NV[d] = nacc;
    }
    v4u ra0, ra1, rb0, rb1, rc0, rc1, gq0, gq1; float rgc = 0.f;
    const float* CIF = (const float*)(C.ws + WS_CIF);
#define S2_LOAD01(st) do { const size_t t0_ = row0 + (size_t)(st) * 64; \
        ra0 = *(const v4u*)(P + (t0_ + (tid >> 4)) * PROJ_N + c0 + (tid & 15) * 8); rb0 = *(const v4u*)(P + (t0_ + (tid >> 4)) * PROJ_N + c1 + (tid & 15) * 8); \
        ra1 = *(const v4u*)(P + (t0_ + 32 + (tid >> 4)) * PROJ_N + c0 + (tid & 15) * 8); rb1 = *(const v4u*)(P + (t0_ + 32 + (tid >> 4)) * PROJ_N + c1 + (tid & 15) * 8); \
        if (MX == 1 && tid < 128) rgc = CIF[(t0_ + (tid >> 1)) * 8 + h + 4 * (tid & 1)]; } while (0)
#define S2_LOAD2(st) do { const size_t t0_ = row0 + (size_t)(st) * 64; \
        rc0 = *(const v4u*)(P + (t0_ + (tid >> 4)) * PROJ_N + c2 + (tid & 15) * 8); rc1 = *(const v4u*)(P + (t0_ + 32 + (tid >> 4)) * PROJ_N + c2 + (tid & 15) * 8); } while (0)
#define S2_STORE01(carry) do { \
        if ((carry) && HALO != 0 && tid >= 448) { const unsigned src_ = offa(HALO + 32 + (tid >> 4), tid & 15), dst_ = offa((tid >> 4) - 28, tid & 15); \
            const v4u o0_ = *(const LAS v4u*)(L + S2_T0 + src_), o1_ = *(const LAS v4u*)(L + S2_T1 + src_); *(LAS v4u*)(L + S2_T0 + dst_) = o0_; *(LAS v4u*)(L + S2_T1 + dst_) = o1_; } \
        *(LAS v4u*)(L + S2_T0 + offa(HALO + (tid >> 4), tid & 15)) = ra0; *(LAS v4u*)(L + S2_T1 + offa(HALO + (tid >> 4), tid & 15)) = rb0; \
        *(LAS v4u*)(L + S2_T0 + offa(HALO + 32 + (tid >> 4), tid & 15)) = ra1; *(LAS v4u*)(L + S2_T1 + offa(HALO + 32 + (tid >> 4), tid & 15)) = rb1; \
        if (MX == 1 && tid < 128) *(LAS float*)(L + S2_CIF + tid * 4) = rgc; } while (0)
#define S2_STORE2() do { *(LAS v4u*)(L + S2_T2 + offa(tid >> 4, tid & 15)) = rc0; *(LAS v4u*)(L + S2_T2 + offa((tid >> 4) + 32, tid & 15)) = rc1; } while (0)
    if (HALO != 0 && tid < 64) {
        const long tr = (long)row0 + (tid >> 4) - HALO; const bool ok = tr >= (long)((size_t)b * SEQ);
        *(LAS v4u*)(L + S2_T0 + offa(tid >> 4, tid & 15)) = ok ? *(const v4u*)(P + (size_t)tr * PROJ_N + c0 + (tid & 15) * 8) : (v4u){0u, 0u, 0u, 0u};
        *(LAS v4u*)(L + S2_T1 + offa(tid >> 4, tid & 15)) = ok ? *(const v4u*)(P + (size_t)tr * PROJ_N + c1 + (tid & 15) * 8) : (v4u){0u, 0u, 0u, 0u};
    }
    __syncthreads();
    const int lane_s = lane;
#define SC_BAR() asm volatile("s_waitcnt lgkmcnt(0)\n\ts_barrier" ::: "memory")
#define S2_SCAL() do { if (MX == 1 && wid == 0) { const int t_ = lane_s; const f32x2 cf_ = *(const LAS f32x2*)(L + S2_CIF + t_ * 8); \
        float b_ = -flog(1.f + fexp(-(cf_.y + fbv))); \
        b_ += dppf<0x111>(0.f, b_); b_ += dppf<0x112>(0.f, b_); b_ += dppf<0x114>(0.f, b_); b_ += dppf<0x118>(0.f, b_);            \
        b_ += dppf<0x142, 0xA>(0.f, b_); b_ += dppf<0x143, 0xC>(0.f, b_);                                                        \
        const float bm_ = __builtin_bit_cast(float, __builtin_amdgcn_readlane(__builtin_bit_cast(int, b_), 31)), be_ = __builtin_bit_cast(float, __builtin_amdgcn_readlane(__builtin_bit_cast(int, b_), 63)); \
        *(LAS float*)(L + S2_EQ + t_ * 4) = fexp(b_ - bm_); *(LAS float*)(L + S2_EK + t_ * 4) = fexp(bm_ - b_ + cf_.x + ibv); \
        if (t_ == 0) *(LAS f32x4*)(L + S2_SC) = (f32x4){fexp(bm_), fexp(be_ - bm_), be_, 0.f}; } } while (0)
    S2_LOAD01(0); S2_LOAD2(0); S2_STORE01(false); S2_STORE2();
    __syncthreads();
    S2_SCAL();
    __syncthreads();
    bf16* Y = (bf16*)(C.ws + WS_Y) + (size_t)(MX == 0 ? 1 : 2) * MTOK * 512;
    const float* nwp = (MX == 0 ? C.gnorm_w : C.cnorm_w) + l * 128;
    for (int st = 0; st < 16; ++st) {
        if (PASS == 1 && st < 15) { S2_LOAD01(st + 1); S2_LOAD2(st + 1); }
#ifndef SCAN_PREP_REP
#define SCAN_PREP_REP 1
#endif
        for (int prep_rep = 0; prep_rep < SCAN_PREP_REP; ++prep_rep) {
            int ln_ = lane; if (MX == 1 && PASS == 2) asm volatile("" : "+v"(ln_));
            const int dl = ln_ & 15, g4 = ln_ >> 4, d = wid * 16 + dl, q4 = (ln_ & 15) >> 2, p4 = ln_ & 3; (void)d; (void)q4; (void)p4; (void)g4;
            float lf[16], qv[16], kv[16];
            if (MX == 0) {
#pragma unroll
                for (int j = 0; j < 4; ++j) { const s16x4 qr = vtr(L + S2_T0 + TRB(offa, 16 * g4 + 4 * j, 2 * wid)), fr = vtr(L + S2_T1 + TRB(offa, 16 * g4 + 4 * j, 2 * wid));
#pragma unroll
                    for (int e = 0; e < 4; ++e) { const float q = bf2f((unsigned)(unsigned short)qr[e]), f = bf2f((unsigned)(unsigned short)fr[e]);
                        const float ex = fexp(-f), sg = frcp(1.f + ex);
                        lf[4 * j + e] = flog(lbv + (1.f - lbv) * sg); kv[4 * j + e] = (1.f - lbv) * ex * sg; qv[4 * j + e] = q * fsigmoid(q); } }
            } else {
                f32x2 u2[20];
#pragma unroll
                for (int j = 0; j < 5; ++j) { const s16x4 qr = vtr(L + S2_T0 + TRB(offa, 16 * g4 + 4 * j, 2 * wid)), kr = vtr(L + S2_T1 + TRB(offa, 16 * g4 + 4 * j, 2 * wid));
#pragma unroll
                    for (int e = 0; e < 4; ++e) u2[4 * j + e] = (f32x2){bf2f((unsigned)(unsigned short)qr[e]), bf2f((unsigned)(unsigned short)kr[e])}; }
                const f32x2 cb2 = {cbq, cbk}, cw2[4] = {{cwq[0], cwk[0]}, {cwq[1], cwk[1]}, {cwq[2], cwk[2]}, {cwq[3], cwk[3]}};
#pragma unroll
                for (int k = 0; k < 16; ++k) { f32x2 a2 = cb2;
#pragma unroll
                    for (int c = 0; c < 4; ++c) a2 = a2 + cw2[c] * u2[k + 1 + c];
                    const float aq = a2.x, ak = a2.y;
                    qv[k] = aq * fsigmoid(aq); kv[k] = ak * fsigmoid(ak) * 0.08838834764831845f;
                    lf[k] = 0.f; }
            }
            float cs[16]; cs[0] = lf[0];
#pragma unroll
            for (int k = 1; k < 16; ++k) cs[k] = cs[k - 1] + lf[k];
            const float t0 = __shfl(cs[15], dl), t1 = __shfl(cs[15], dl + 16), t2 = __shfl(cs[15], dl + 32), t3 = __shfl(cs[15], dl + 48);
            const float bm = t0 + t1, bend = bm + (t2 + t3);
            const float off = (g4 == 0 ? 0.f : g4 == 1 ? t0 : g4 == 2 ? bm : bm + t2) - bm;
            float qb16[16], kb16[16]; float ksl = 0.f;
            if (MX == 1) {
#pragma unroll
                for (int k4 = 0; k4 < 4; ++k4) { const f32x4 eq = *(const LAS f32x4*)(L + S2_EQ + (16 * g4 + 4 * k4) * 4), ek = *(const LAS f32x4*)(L + S2_EK + (16 * g4 + 4 * k4) * 4);
#pragma unroll
                    for (int e = 0; e < 4; ++e) { const int k = 4 * k4 + e; const float ku = kv[k] * ek[e]; ksl += ku; kb16[k] = ku; qb16[k] = qv[k] * eq[e]; } }
            } else {
#pragma unroll
            for (int k = 0; k < 16; ++k) { const float bj = off + cs[k]; const float ku = kv[k] * fexp(-bj); ksl += ku; kb16[k] = ku; qb16[k] = qv[k] * fexp(bj); }
            }
            if (PASS == 2) { *(LAS v4u*)(L + S2_QT + off2(d, 2 * g4)) = (v4u){pk2(qb16[0], qb16[1]), pk2(qb16[2], qb16[3]), pk2(qb16[4], qb16[5]), pk2(qb16[6], qb16[7])};
                             *(LAS v4u*)(L + S2_QT + off2(d, 2 * g4 + 1)) = (v4u){pk2(qb16[8], qb16[9]), pk2(qb16[10], qb16[11]), pk2(qb16[12], qb16[13]), pk2(qb16[14], qb16[15])}; }
            *(LAS v4u*)(L + S2_KU + off2(d, 2 * g4)) = (v4u){pk2(kb16[0], kb16[1]), pk2(kb16[2], kb16[3]), pk2(kb16[4], kb16[5]), pk2(kb16[6], kb16[7])};
            *(LAS v4u*)(L + S2_KU + off2(d, 2 * g4 + 1)) = (v4u){pk2(kb16[8], kb16[9]), pk2(kb16[10], kb16[11]), pk2(kb16[12], kb16[13]), pk2(kb16[14], kb16[15])};
            if (MX == 1) { ksl += __shfl_xor(ksl, 16); ksl += __shfl_xor(ksl, 32); }
            const f32x4 scl_ = MX == 1 ? *(const LAS f32x4*)(L + S2_SC) : (f32x4){0.f, 0.f, 0.f, 0.f};
            if (g4 == 0) { *(LAS float*)(L + S2_AM + d * 4) = MX == 1 ? scl_.x : fexp(bm); *(LAS float*)(L + S2_AE + d * 4) = MX == 1 ? scl_.y : fexp(bend - bm); if (MX == 1) { *(LAS float*)(L + S2_KS + d * 4) = ksl; if (prep_rep == 0) *(LAS float*)(L + S2_NS + d * 4) = scl_.x * NV[d]; } }
            if (prep_rep == 0) bsum += (MX == 1 ? scl_.z : bend);
        }
        if (PASS == 2 && st < 15) S2_LOAD01(st + 1);
        SC_BAR();
        if (PASS == 2) {
            int ln_ = lane; if (MX == 1 && PASS == 2) asm volatile("" : "+v"(ln_));
            const int dl = ln_ & 15, g4 = ln_ >> 4, d = wid * 16 + dl, q4 = (ln_ & 15) >> 2, p4 = ln_ & 3; (void)d; (void)q4; (void)p4; (void)g4;
            const unsigned cA0 = 1024u * g4 + 64u * q4 + 8u * (p4 & 1) + 16u * (unsigned)(p4 >> 1), cA1 = 1024u * g4 + 256u + 64u * q4 + 8u * (p4 & 1) + 16u * (unsigned)((p4 >> 1) ^ 1);
            const unsigned xs = (unsigned)((dl >> 2) & 3), cS = 1024u * (dl >> 3) + 64u * (dl & 7) + 8u * (g4 & 1) + 16u * (unsigned)((g4 >> 1) ^ (xs & 1));
#pragma unroll
            for (int rep = 0; rep < 2; ++rep) { const int ti = wid + 8 * rep;
                if (ti < 10) { const int tt = ti < 1 ? 0 : ti < 3 ? 1 : ti < 6 ? 2 : 3, ts = ti - (tt * (tt + 1)) / 2;
                    const unsigned kofs = 32u * (unsigned)((ts & 1) ^ (g4 & 1)) + 512u * (unsigned)(ts >> 1), qofs = 32u * (unsigned)((tt & 1) ^ (g4 & 1)) + 512u * (unsigned)(tt >> 1);
                    const LAS unsigned char* ka0 = L + S2_KU + cA0 + kofs; const LAS unsigned char* ka1 = L + S2_KU + cA1 + kofs;
                    const LAS unsigned char* qa0 = L + S2_QT + cA0 + qofs; const LAS unsigned char* qa1 = L + S2_QT + cA1 + qofs;
                    f32x4 at = (f32x4){0.f, 0.f, 0.f, 0.f};
#pragma unroll
                    for (int kk = 0; kk < 4; ++kk) { const s16x4 a0 = vtr(ka0 + 4096 * kk), a1 = vtr(ka1 + 4096 * kk), b0 = vtr(qa0 + 4096 * kk), b1 = vtr(qa1 + 4096 * kk);
                        at = __builtin_amdgcn_mfma_f32_16x16x32_bf16((bf16x8){a0[0], a0[1], a0[2], a0[3], a1[0], a1[1], a1[2], a1[3]}, (bf16x8){b0[0], b0[1], b0[2], b0[3], b1[0], b1[1], b1[2], b1[3]}, at, 0, 0, 0); }
                    if (ts == tt) {
#pragma unroll
                        for (int r = 0; r < 4; ++r) at[r] = (4 * g4 + r <= dl) ? at[r] : 0.f; }
                    LAS unsigned char* sp = L + S2_ATT + cS + 2048u * (unsigned)tt;
                    *(LAS v2u*)(sp + 32u * (unsigned)((ts & 1) ^ (xs >> 1)) + 512u * (unsigned)(ts >> 1)) = (v2u){pk2(at[0], at[1]), pk2(at[2], at[3])};
                    if (ts == tt && (tt & 1) == 0) *(LAS v2u*)(sp + 32u * (unsigned)(((ts + 1) & 1) ^ (xs >> 1)) + 512u * (unsigned)((ts + 1) >> 1)) = (v2u){0u, 0u};
                } }
        }
        SC_BAR();
        {
            int ln_ = lane; if (MX == 1 && PASS == 2) asm volatile("" : "+v"(ln_));
            const int dl = ln_ & 15, g4 = ln_ >> 4, d = wid * 16 + dl, q4 = (ln_ & 15) >> 2, p4 = ln_ & 3; (void)d; (void)q4; (void)p4; (void)g4;
#pragma unroll
            for (int i = 0; i < 8; ++i) S[i] = S[i] * *(const LAS f32x4*)(L + S2_AM + (16 * i + 4 * g4) * 4);
            bf16x8 vfr[2];
            const unsigned cE = 2048u * g4 + 512u * (unsigned)(wid >> 1) + 64u * q4 + 8u * (p4 & 1) + 32u * (unsigned)((wid & 1) ^ (g4 & 1));
            const LAS unsigned char* ve0 = L + S2_T2 + cE + 16u * (unsigned)(p4 >> 1); const LAS unsigned char* ve1 = L + S2_T2 + cE + 256u + 16u * (unsigned)((p4 >> 1) ^ 1);
            const unsigned cC = 1024u * (dl >> 3) + 64u * (dl & 7) + 16u * (unsigned)(g4 ^ ((dl >> 2) & 3));
            const unsigned cB = 1024u * (g4 >> 1) + 256u * (g4 & 1) + 64u * q4 + 8u * (p4 & 1) + 16u * (unsigned)((p4 >> 1) ^ (g4 & 1));
#pragma unroll
            for (int ks = 0; ks < 2; ++ks) { const s16x4 v0 = vtr(ve0 + 8192 * ks), v1 = vtr(ve1 + 8192 * ks);
                vfr[ks] = (bf16x8){v0[0], v0[1], v0[2], v0[3], v1[0], v1[1], v1[2], v1[3]}; }
            if (PASS == 2 && st < 15) S2_LOAD2(st + 1);
            if (PASS == 2) { const size_t grow_ = row0 + (size_t)st * 64 + (tid >> 3); gq0 = *(const v4u*)(P + grow_ * PROJ_N + c3 + (tid & 7) * 16); gq1 = *(const v4u*)(P + grow_ * PROJ_N + c3 + (tid & 7) * 16 + 8); }
            if (PASS == 2) {
                bf16x8 sfr[4];
#pragma unroll
                for (int kk = 0; kk < 4; ++kk) sfr[kk] = __builtin_bit_cast(bf16x8, (v4u){pk2(S[2 * kk][0], S[2 * kk][1]), pk2(S[2 * kk][2], S[2 * kk][3]), pk2(S[2 * kk + 1][0], S[2 * kk + 1][1]), pk2(S[2 * kk + 1][2], S[2 * kk + 1][3])});
                bf16x8 nfr[4], onesf;
                if (MX == 1) {
#pragma unroll
                    for (int kk = 0; kk < 4; ++kk) { const f32x4 n0 = *(const LAS f32x4*)(L + S2_NS + (32 * kk + 4 * g4) * 4), n1 = *(const LAS f32x4*)(L + S2_NS + (32 * kk + 16 + 4 * g4) * 4);
                        nfr[kk] = dl == 0 ? __builtin_bit_cast(bf16x8, (v4u){pk2(n0.x, n0.y), pk2(n0.z, n0.w), pk2(n1.x, n1.y), pk2(n1.z, n1.w)}) : __builtin_bit_cast(bf16x8, (v4u){0u, 0u, 0u, 0u}); }
                    const unsigned o2 = dl == 0 ? 0x3F803F80u : 0u; onesf = __builtin_bit_cast(bf16x8, (v4u){o2, o2, o2, o2});
                }
#pragma unroll 2
                for (int tt = 0; tt < 4; ++tt) {
                    f32x4 O = (f32x4){0.f, 0.f, 0.f, 0.f}, dacc = (f32x4){0.f, 0.f, 0.f, 0.f};
                    const LAS unsigned char* qb = L + S2_QT + cB + 32u * (unsigned)((tt & 1) ^ (g4 >> 1)) + 512u * (unsigned)(tt >> 1);
#pragma unroll
                    for (int kk = 0; kk < 4; ++kk) { const s16x4 a0 = vtr(qb + 4096 * kk), a1 = vtr(qb + 4096 * kk + 2048);
                        const bf16x8 qa = (bf16x8){a0[0], a0[1], a0[2], a0[3], a1[0], a1[1], a1[2], a1[3]};
                        O = __builtin_amdgcn_mfma_f32_16x16x32_bf16(qa, sfr[kk], O, 0, 0, 0);
                        if (MX == 1) dacc = __builtin_amdgcn_mfma_f32_16x16x32_bf16(qa, nfr[kk], dacc, 0, 0, 0); }
#pragma unroll
                    for (int ks = 0; ks < 2; ++ks) if (ks <= (tt >> 1)) { const v4u ar = *(const LAS v4u*)(L + S2_ATT + cC + 2048u * (unsigned)tt + 512u * (unsigned)ks);
                        O = __builtin_amdgcn_mfma_f32_16x16x32_bf16(__builtin_bit_cast(bf16x8, ar), vfr[ks], O, 0, 0, 0);
                        if (MX == 1) dacc = __builtin_amdgcn_mfma_f32_16x16x32_bf16(__builtin_bit_cast(bf16x8, ar), onesf, dacc, 0, 0, 0); }
                    if (MX == 1) {
#pragma unroll
                        for (int r = 0; r < 4; ++r) O[r] *= dppf<0x150>(0.f, frcp(fmaxf(fabsf(dacc[r]), 1.0f))); }
#pragma unroll
                    for (int r = 0; r < 4; ++r) *(LAS float*)(L + S2_OST + (16 * tt + 4 * g4 + r) * 512 + d * 4) = O[r];
                }
            }
            if (st < 15) S2_STORE01(true);
#pragma unroll
            for (int i = 0; i < 8; ++i) {
#pragma unroll
                for (int ks = 0; ks < 2; ++ks) { const v4u kr = *(const LAS v4u*)(L + S2_KU + cC + 2048 * i + 512 * ks); S[i] = __builtin_amdgcn_mfma_f32_16x16x32_bf16(__builtin_bit_cast(bf16x8, kr), vfr[ks], S[i], 0, 0, 0); }
                S[i] = S[i] * *(const LAS f32x4*)(L + S2_AE + (16 * i + 4 * g4) * 4); }
        }
        SC_BAR();
        if (st < 15) S2_STORE2();
        if (st < 15) S2_SCAL();
        { int ln_ = lane; const int dl = ln_ & 15, g4 = ln_ >> 4, d = wid * 16 + dl;
        if (MX == 1 && g4 == 0) NV[d] = *(const LAS float*)(L + S2_AE + d * 4) * (*(const LAS float*)(L + S2_AM + d * 4) * NV[d] + *(const LAS float*)(L + S2_KS + d * 4));
        }
        if (PASS == 2) {
            int tl_ = tid;
            const int t = tl_ >> 3, cb = tl_ & 7; const size_t grow = row0 + (size_t)st * 64 + t;
            const v4u g0 = gq0, g1 = gq1;
            f32x4 ov[4]; float ss = 0.f;
#pragma unroll
            for (int k = 0; k < 4; ++k) { ov[k] = *(const LAS f32x4*)(L + S2_OST + t * 512 + (cb * 16 + 4 * k) * 4); ss += (ov[k].x * ov[k].x + ov[k].y * ov[k].y) + (ov[k].z * ov[k].z + ov[k].w * ov[k].w); }
            ss += __shfl_xor(ss, 1); ss += __shfl_xor(ss, 2); ss += __shfl_xor(ss, 4);
            const float rstd = __builtin_amdgcn_rsqf(ss * (1.0f / 128.0f) + NORM_EPS);
            float gt[16] = {bflo(g0.x), bfhi(g0.x), bflo(g0.y), bfhi(g0.y), bflo(g0.z), bfhi(g0.z), bflo(g0.w), bfhi(g0.w), bflo(g1.x), bfhi(g1.x), bflo(g1.y), bfhi(g1.y), bflo(g1.z), bfhi(g1.z), bflo(g1.w), bfhi(g1.w)};
            float ov16[16];
#pragma unroll
            for (int k = 0; k < 4; ++k) { const f32x4 nwv = *(const f32x4*)(nwp + cb * 16 + 4 * k);
#pragma unroll
                for (int e = 0; e < 4; ++e) { const float gg = gt[4 * k + e]; ov16[4 * k + e] = ov[k][e] * rstd * nwv[e] * ((MX == 0) ? gg * fsigmoid(gg) : fsigmoid(gg)); } }
            v4u o0, o1; o0.x = pk2(ov16[0], ov16[1]); o0.y = pk2(ov16[2], ov16[3]); o0.z = pk2(ov16[4], ov16[5]); o0.w = pk2(ov16[6], ov16[7]);
            o1.x = pk2(ov16[8], ov16[9]); o1.y = pk2(ov16[10], ov16[11]); o1.z = pk2(ov16[12], ov16[13]); o1.w = pk2(ov16[14], ov16[15]);
            *(v4u*)(Y + grow * 512 + h * 128 + cb * 16) = o0; *(v4u*)(Y + grow * 512 + h * 128 + cb * 16 + 8) = o1;
        }
        SC_BAR();
    }
#undef SC_BAR
#undef S2_SCAL
#undef S2_LOAD01
#undef S2_LOAD2
#undef S2_STORE01
#undef S2_STORE2
#undef TRB
    if (PASS == 1) {
        f32x4* STSw = (f32x4*)(C.ws + WS_STS);
#pragma unroll
        for (int i = 0; i < 8; ++i) STSw[((size_t)(unit * 8 + wid) * 8 + i) * 64 + lane] = S[i];
        if (g4 == 0) { ((float*)(C.ws + WS_STA))[unit * 128 + d] = fexp(bsum); ((float*)(C.ws + WS_STN))[unit * 128 + d] = (MX == 1) ? NV[d] : 0.f; }
    }
    __syncthreads();
}
template <int PASS>
__device__ __forceinline__ void phase_scan(const Ctx& C, const WG& w, int l) {
    for (int u = w.bid; u < 256; u += w.G) {
        const int seg = u & 15, h = (u >> 4) & 3, b = (u >> 6) & 1;
        if (u < 128) scan_unit<0, PASS>(C, w, l, b, h, seg); else scan_unit<1, PASS>(C, w, l, b, h, seg);
    }
}

constexpr int NPHASE = 1 + DEPTH * 11 - DEPTH / 2 + 1;
#ifndef REP_PH
#define REP_PH -1
#endif
#define REP(k, ...) do { __VA_ARGS__; if (REP_PH == (k)) { __syncthreads(); __VA_ARGS__; } } while (0)
struct Args { const float* in[31]; float* out; unsigned char* ws; int ph_lo, ph_hi; };
__device__ __forceinline__ int opaque_zero() { int z; asm volatile("s_mov_b32 %0, 0" : "=s"(z)); return z; }
#define MKC() WG w; { int t_ = TIDNOW(); asm volatile("" : "+v"(t_)); w.lds = (LAS unsigned char*)lds_raw; w.tid = t_; w.lane = t_ & 63; w.wave = wave0; w.G = gridDim.x; w.bid = blockIdx.x; asm volatile("" : "+s"(w.wave), "+s"(w.G), "+s"(w.bid)); } \
    Ctx C; { const int z_ = opaque_zero(); \
    C.x = args.in[0 + z_]; C.c = args.in[1 + z_]; C.w_mod = args.in[2 + z_]; C.b_mod = args.in[3 + z_]; C.norm1_w = args.in[4 + z_]; C.norm2_w = args.in[5 + z_]; C.w_in = args.in[6 + z_]; C.conv_w = args.in[7 + z_]; C.conv_b = args.in[8 + z_]; \
    C.qn_w = args.in[9 + z_]; C.kn_w = args.in[10 + z_]; C.lq1 = args.in[11 + z_]; C.lk1 = args.in[12 + z_]; C.lq2 = args.in[13 + z_]; C.lk2 = args.in[14 + z_]; C.subln_w = args.in[15 + z_]; C.lb_logits = args.in[16 + z_]; C.gnorm_w = args.in[17 + z_]; \
    C.ig_b = args.in[18 + z_]; C.fg_b = args.in[19 + z_]; C.cnorm_w = args.in[20 + z_]; C.w_branch = args.in[21 + z_]; C.w_out = args.in[22 + z_]; C.ffn_w1 = args.in[23 + z_]; C.ffn_w3 = args.in[24 + z_]; C.ffn_w2 = args.in[25 + z_]; \
    C.router_w = args.in[26 + z_]; C.router_b = args.in[27 + z_]; C.moe_w1 = args.in[28 + z_]; C.moe_w3 = args.in[29 + z_]; C.moe_w2 = args.in[30 + z_]; C.out = args.out; C.ws = args.ws; asm volatile("" : "+s"(C.ws), "+s"(C.out)); }
__global__ void __launch_bounds__(NTHR, 2) fwd_kernel(Args args) {
    extern __shared__ __attribute__((aligned(16))) unsigned char lds_raw[];
    const int wave0 = __builtin_amdgcn_readfirstlane((int)threadIdx.x >> 6);
#define TIDNOW() (wave0 * 64 + lane_now())
    unsigned char* const wsb = args.ws;
    for (int u = TIDNOW(); u < (LDS_BYTES - RING_BYTES) / 4; u += NTHR) ((LAS unsigned*)((LAS unsigned char*)lds_raw + RING_BYTES))[u] = 0u;
    __syncthreads();
    volatile LAS unsigned* MISC = (volatile LAS unsigned*)((LAS unsigned char*)lds_raw + MISC_OFF);
    XcdBarrier bar; bar.bar = (unsigned*)wsb + CW_BAR; bar.x = 0; bar.st = nullptr;
    const int lo = args.ph_lo, hi = args.ph_hi;
    if (hi - lo > 1) bar = xcd_barrier_post((unsigned*)wsb + CW_BAR, MISC + 8, TIDNOW() == 0);
    int ph = 0;
#define PH_RUN (ph >= lo && ph < hi)
#define PH_END do { if (PH_RUN && ph + 1 < hi) xcd_barrier(bar, TIDNOW() == 0); ++ph; } while (0)
#define H ((bf16*)(C.ws + WS_H))
#define PROJ ((bf16*)(C.ws + WS_PROJ))
#define MOD ((const float*)(C.ws + WS_MOD))

    if (PH_RUN) { MKC(); REP(0, phase_prologue(C, w)); }
    PH_END;
    for (int l = 0; l < DEPTH; ++l) {
        const bool moe = (l & 1) != 0;
        if (PH_RUN) { MKC(); if (l == 0) { phase_cvt_qwin(C, w); phase_cvt_q13d(C, w); __syncthreads(); }
            phase_norm<0>(C, w, l, l > 0 && ((l - 1) & 1) != 0); if (REP_PH == 1 && !(l > 0 && ((l - 1) & 1) != 0)) { __syncthreads(); phase_norm<0>(C, w, l, false); } }
        PH_END;
        if (PH_RUN) { MKC(); pg8::Gemm g{H, (const bf16*)(C.ws + WS_WIN + (size_t)l * WIN_ROWS * 1024), MTOK, WIN_ROWS, 512}; pg8::StaticOrder S; S.init(MTOK, WIN_ROWS, w.G, w.bid);
            pg8::EpiProj E{PROJ, C.qn_w + l * 64, C.kn_w + l * 64, (unsigned char*)(C.ws + WS_GATE8), (const float*)(C.ws + WS_SA), (const float*)C.ws + CM_WIN + l * WIN_ROWS}; REP(2, (pg8::gemm_phase<pg8::EpiProj, pg8::StaticOrder, true, true>(w.lds, g, S, E, w.tid))); }
        PH_END;
        if (PH_RUN) { MKC(); REP(3, phase_scan<1>(C, w, l)); }
        PH_END;
        if (PH_RUN) { MKC(); REP(4, phase_scan<2>(C, w, l)); phase_attention(C, w, l); if (REP_PH == 5) { __syncthreads(); phase_attention(C, w, l, 1); } }
        PH_END;
        if (PH_RUN) { MKC(); REP(6, phase_attn_combine(C, w, l)); }
        PH_END;
        if (PH_RUN) { MKC();
            pg8::StaticOrder S; S.init(MTOK, 1024, w.G, w.bid);
            const bf16* Y = (const bf16*)(C.ws + WS_Y); const bf16* WB = (const bf16*)(C.ws + WS_WBR) + (size_t)l * 3 * 1024 * 512;
            { pg8::MergeOrder MS; MS.S = S; pg8::Gemm g{Y, WB, MTOK, 1024, 512}; pg8::EpiMergeChain E{(const unsigned char*)(C.ws + WS_GATE8), H};
              REP(7, (pg8::gemm_phase<pg8::EpiMergeChain, pg8::MergeOrder, true, true>(w.lds, g, MS, E, w.tid))); }
        }
        PH_END;
        if (PH_RUN) { MKC(); pg8::Gemm g{H, (const bf16*)(C.ws + WS_WOUT) + (size_t)l * 1024 * 1024, MTOK, 1024, 1024}; pg8::StaticOrder S; S.init(MTOK, 1024, w.G, w.bid);
            pg8::EpiResid E{l == 0 ? C.x : nullptr, (bf16*)(C.ws + WS_XB), MOD + (size_t)l * 2 * 6144 + 2048}; pg8::gemm_phase<pg8::EpiResid, pg8::StaticOrder, true, true>(w.lds, g, S, E, w.tid); }
        PH_END;
        if (PH_RUN) { MKC(); if (moe) { phase_norm<2>(C, w, l, false); amx_run(C, w, 1 + (l >> 1)); } else { REP(13, phase_norm<1>(C, w, l, false)); } }
        PH_END;
        if (moe) { if (PH_RUN) { MKC(); REP(12, phase_gather(C, w, l >> 1)); __syncthreads(); REP(11, phase_cvt_moe(C, w, l >> 1)); }
            PH_END; }
        if (PH_RUN) { MKC();
            if (!moe) { pg8::StaticOrder S; S.init(MTOK, 5632, w.G, w.bid);
#if I8_DENSE == 1
                pg8::Gemm g{H, (const bf16*)(C.ws + WS_W13D + (size_t)(l >> 1) * 5632 * 1024), MTOK, 5632, 512};
                pg8::EpiSwiglu E{(bf16*)(C.ws + WS_U), (const float*)(C.ws + WS_SA), (const float*)C.ws + CM_W13D + (l >> 1) * 5632}; REP(9, (pg8::gemm_phase<pg8::EpiSwiglu, pg8::StaticOrder, true, true>(w.lds, g, S, E, w.tid)));
#else
                pg8::Gemm g{H, (const bf16*)(C.ws + WS_W13D) + (size_t)(l >> 1) * 5632 * 1024, MTOK, 5632, 1024};
                pg8::EpiSwigluBf E{(bf16*)(C.ws + WS_U)}; REP(9, (pg8::gemm_phase<pg8::EpiSwigluBf, pg8::StaticOrder, true, true>(w.lds, g, S, E, w.tid)));
#endif
            }
            else { const int* gm = (const int*)(C.ws + WS_META); const int rows = __builtin_amdgcn_readfirstlane(gm[16]);
                pg8::MoeOrder S; S.S.init(rows, 5632, w.G, w.bid); S.nN = 22;
#pragma unroll
                for (int e = 0; e < NEXP; ++e) S.ts[e] = __builtin_amdgcn_readfirstlane(gm[8 + e]) >> 8;
                LAS unsigned short* toks = (LAS unsigned short*)(w.lds + TOK_LDS); const unsigned short* TOK = (const unsigned short*)(C.ws + WS_TOK);
                for (int i = 0; i < TOK_UNITS; ++i) { pg8::Unit u; if (!S.next(i, u)) break; if (w.tid < 256) toks[i * 256 + w.tid] = TOK[u.pm * 256 + w.tid]; }
                __syncthreads();
#if I8_MOE
                pg8::Gemm g{H, (const bf16*)(C.ws + WS_W13M), rows, 5632, 512};
                pg8::EpiSwiglu E{(bf16*)(C.ws + WS_U), (const float*)(C.ws + WS_SAP), (const float*)C.ws + CM_W13M + (l >> 1) * NEXP * 5632}; REP(9, (pg8::gemm_phase<pg8::EpiSwiglu, pg8::MoeOrder, true, true, true>(w.lds, g, S, E, w.tid, toks)));
#else
                pg8::Gemm g{H, (const bf16*)(C.ws + WS_W13M), rows, 5632, 1024};
                pg8::EpiSwigluBf E{(bf16*)(C.ws + WS_U)}; REP(9, (pg8::gemm_phase<pg8::EpiSwigluBf, pg8::MoeOrder, true, true, true>(w.lds, g, S, E, w.tid, toks)));
#endif
            }
        }
        PH_END;
        if (PH_RUN) { MKC();
            if (!moe) { pg8::Gemm g{(const bf16*)(C.ws + WS_U), (const bf16*)(C.ws + WS_W2D) + (size_t)(l >> 1) * 1024 * DFF, MTOK, 1024, DFF}; pg8::StaticOrder S; S.init(MTOK, 1024, w.G, w.bid);
                pg8::EpiResid E{nullptr, (bf16*)(C.ws + WS_XB), MOD + (size_t)l * 2 * 6144 + 5120}; pg8::gemm_phase<pg8::EpiResid, pg8::StaticOrder, true, true>(w.lds, g, S, E, w.tid); }
            else { const int* gm = (const int*)(C.ws + WS_META); const int rows = __builtin_amdgcn_readfirstlane(gm[16]);
                pg8::MoeOrder S; S.S.init(rows, 1024, w.G, w.bid); S.nN = 4;
#pragma unroll
                for (int e = 0; e < NEXP; ++e) S.ts[e] = __builtin_amdgcn_readfirstlane(gm[8 + e]) >> 8;
                pg8::Gemm g{(const bf16*)(C.ws + WS_U), (const bf16*)(C.ws + WS_W2M), rows, 1024, DFF};
                pg8::EpiMoeOut E{(bf16*)(C.ws + WS_AS), (const float*)(C.ws + WS_WPOS)}; REP(10, (pg8::gemm_phase<pg8::EpiMoeOut, pg8::MoeOrder, true, true>(w.lds, g, S, E, w.tid))); }
        }
        PH_END;
    }
    if (PH_RUN) { MKC(); phase_final_combine(C, w, DEPTH - 1); }
#undef PH_RUN
#undef PH_END
#undef H
#undef PROJ
#undef MOD
}

extern "C" void kernel_launch(void* const* d_in, const int* in_sizes, int n_in, void* d_out, int out_size, void* d_ws, size_t ws_size, hipStream_t stream) {
    static int grid = 0;
    if (grid == 0) {
        if (n_in != 31 || out_size != MTOK * DM || ws_size < WS_END) { fprintf(stderr, "kernel_launch: unexpected problem (n_in %d, out %d, ws %zu)\n", n_in, out_size, ws_size); grid = -1; return; }
        int dev = 0, cus = 0, per_cu = 0;
        if (hipGetDevice(&dev) != hipSuccess || hipDeviceGetAttribute(&cus, hipDeviceAttributeMultiprocessorCount, dev) != hipSuccess) { grid = -1; return; }
        if (hipFuncSetAttribute((const void*)fwd_kernel, hipFuncAttributeMaxDynamicSharedMemorySize, LDS_BYTES) != hipSuccess) { grid = -1; return; }
        if (hipOccupancyMaxActiveBlocksPerMultiprocessor(&per_cu, (const void*)fwd_kernel, NTHR, LDS_BYTES) != hipSuccess || per_cu < 1) fprintf(stderr, "kernel_launch: occupancy query reports %d\n", per_cu);
        (void)hipGetLastError();
        grid = cus;
    }
    if (grid < 0) return;
    if (hipMemsetAsync((char*)d_ws + WS_CTL, 0, CTL_ZERO_BYTES, stream) != hipSuccess) return;
    Args a{};
    for (int i = 0; i < 31; ++i) a.in[i] = (const float*)d_in[i];
    a.out = (float*)d_out; a.ws = (unsigned char*)d_ws;
#if MK_PER_PHASE
    for (int p = 0; p < NPHASE; ++p) { a.ph_lo = p; a.ph_hi = p + 1; hipLaunchKernelGGL(fwd_kernel, dim3(grid), dim3(NTHR), LDS_BYTES, stream, a); }
#else
    a.ph_lo = 0; a.ph_hi = NPHASE; hipLaunchKernelGGL(fwd_kernel, dim3(grid), dim3(NTHR), LDS_BYTES, stream, a);
#endif
}
```
